# Optimizing an MI355X kernel written in HIP

```python
import math
import jax, jax.numpy as jnp
from jax import lax
import numpy as np

D_MODEL = 1024
BATCH = 4
SEQ = 4096
DEPTH = 4

CHUNK = 64
HEAD_DIM = 64
N_SELF_HEADS = 12
N_DIFF_HEADS = 6
N_MEM_HEADS = 4
N_MEM = 256
SELF_WIDTH = N_SELF_HEADS * HEAD_DIM
MEM_WIDTH = N_MEM_HEADS * HEAD_DIM
IN_WIDTH = 3 * SELF_WIDTH + MEM_WIDTH
LEFT_CHUNKS = 8
BAND = (LEFT_CHUNKS + 1) * CHUNK
REL_CLIP = 128
N_REL = 2 * REL_CLIP + 1
Q_BLOCK = 128
D_FF = 2816
ROPE_THETA = 10000.0
EPS = 1e-6
NEG_INF = -1e30
N_MIXERS = 2
N_A_LAYERS = (DEPTH + 1) // 2
N_B_LAYERS = DEPTH // 2

kernel_name = 'hybrid_chunked_diff_memory_macaron'


def rmsnorm(x, g):
    x32 = x.astype(jnp.float32)
    y = x32 * lax.rsqrt(jnp.mean(x32 * x32, axis=-1, keepdims=True) + EPS)
    return (y * g.astype(jnp.float32)).astype(x.dtype)


def swiglu(h, w_gate, w_up, w_down):
    return (jax.nn.silu(h @ w_gate) * (h @ w_up)) @ w_down


def rope_tables(positions):
    inv_freq = 1.0 / (ROPE_THETA ** (jnp.arange(0, HEAD_DIM, 2, dtype=jnp.float32) / HEAD_DIM))
    ang = positions.astype(jnp.float32)[..., None] * inv_freq
    return jnp.cos(ang), jnp.sin(ang)


def apply_rope(x, cos, sin):
    x32 = x.astype(jnp.float32)
    x1, x2 = jnp.split(x32, 2, axis=-1)
    return jnp.concatenate([x1 * cos - x2 * sin, x2 * cos + x1 * sin], axis=-1).astype(x.dtype)


def chunked_rel_attention(q, k, v, rel_bias):
    B, S, H, D = q.shape
    n_chunks = S // CHUNK
    pad = ((0, 0), (LEFT_CHUNKS * CHUNK, 0), (0, 0), (0, 0))
    kp = jnp.pad(k, pad)
    vp = jnp.pad(v, pad)
    qi = jnp.arange(CHUNK)[:, None]
    ks = jnp.arange(BAND)[None, :]
    rel = LEFT_CHUNKS * CHUNK + qi - ks
    bias = rel_bias[:, jnp.clip(rel, -REL_CLIP, REL_CLIP) + REL_CLIP].astype(jnp.float32)
    scale = HEAD_DIM ** -0.5
    slot = jnp.arange(BAND)

    def one_chunk(c):
        start = c * CHUNK
        qc = lax.dynamic_slice_in_dim(q, start, CHUNK, axis=1)
        kc = lax.dynamic_slice_in_dim(kp, start, BAND, axis=1)
        vc = lax.dynamic_slice_in_dim(vp, start, BAND, axis=1)
        s = jnp.einsum('bqhd,bkhd->bhqk', qc, kc).astype(jnp.float32) * scale + bias
        valid = slot >= (LEFT_CHUNKS - c) * CHUNK
        s = jnp.where(valid, s, NEG_INF)
        p = jax.nn.softmax(s, axis=-1).astype(v.dtype)
        return jnp.einsum('bhqk,bkhd->bqhd', p, vc)

    out = lax.map(one_chunk, jnp.arange(n_chunks))
    return out.transpose(1, 0, 2, 3, 4).reshape(B, S, H, D)


def diff_attention(q, k, v, lam):
    B, S, H, _, D = q.shape
    n_blocks = S // Q_BLOCK
    scale = D ** -0.5
    k_chunk = jnp.arange(S) // CHUNK
    qb = q.reshape(B, n_blocks, Q_BLOCK, H, 2, D).transpose(1, 0, 2, 3, 4, 5)

    def one_block(args):
        q_blk, b = args
        s = jnp.einsum('bqhcd,bkhcd->bhcqk', q_blk, k).astype(jnp.float32) * scale
        q_chunk = (b * Q_BLOCK + jnp.arange(Q_BLOCK)) // CHUNK
        allowed = k_chunk[None, :] <= q_chunk[:, None]
        s = jnp.where(allowed, s, NEG_INF)
        p = jax.nn.softmax(s, axis=-1)
        a = (p[:, :, 0] - lam * p[:, :, 1]).astype(v.dtype)
        return jnp.einsum('bhqk,bkhe->bqhe', a, v)

    out = lax.map(one_block, (qb, jnp.arange(n_blocks)))
    return out.transpose(1, 0, 2, 3, 4).reshape(B, S, H, v.shape[-1])


def memory_attention(q, k, v):
    s = jnp.einsum('bshd,bnhd->bhsn', q, k).astype(jnp.float32) * (HEAD_DIM ** -0.5)
    p = jax.nn.softmax(s, axis=-1).astype(v.dtype)
    return jnp.einsum('bhsn,bnhd->bshd', p, v)


def setup_inputs(seed: int = 0) -> dict:
    key = jax.random.key(seed)
    ks = iter(jax.random.split(key, 40))
    f32 = jnp.float32

    def nrm(shape, scale):
        return jax.random.normal(next(ks), shape, f32) * scale

    def gain(shape):
        return 1.0 + 0.02 * jax.random.normal(next(ks), shape, f32)

    x = nrm((BATCH, SEQ, D_MODEL), 1.0)
    mem = nrm((BATCH, N_MEM, D_MODEL), 1.0)
    offset = jax.random.randint(next(ks), (BATCH, 1), 0, SEQ, dtype=jnp.int32)
    positions = offset + jnp.arange(SEQ, dtype=jnp.int32)[None, :]
    return {
        'x': x,
        'mem': mem,
        'positions': positions,
        'ffn1_norm': gain((DEPTH, D_MODEL)),
        'ffn1_w_gate': nrm((DEPTH, D_MODEL, D_FF), D_MODEL ** -0.5),
        'ffn1_w_up': nrm((DEPTH, D_MODEL, D_FF), D_MODEL ** -0.5),
        'ffn1_w_down': nrm((DEPTH, D_FF, D_MODEL), D_FF ** -0.5),
        'mix_norm': gain((DEPTH, D_MODEL)),
        'mem_norm': gain((DEPTH, D_MODEL)),
        'w_in': nrm((DEPTH, D_MODEL, IN_WIDTH), D_MODEL ** -0.5),
        'w_mem_kv': nrm((DEPTH, D_MODEL, 2 * MEM_WIDTH), D_MODEL ** -0.5),
        'mem_q_norm': gain((DEPTH, HEAD_DIM)),
        'mem_k_norm': gain((DEPTH, HEAD_DIM)),
        'w_out': nrm((DEPTH, SELF_WIDTH + MEM_WIDTH, D_MODEL), (SELF_WIDTH + MEM_WIDTH) ** -0.5),
        'a_q_norm': gain((N_A_LAYERS, HEAD_DIM)),
        'a_k_norm': gain((N_A_LAYERS, HEAD_DIM)),
        'a_rel_bias': nrm((N_A_LAYERS, N_SELF_HEADS, N_REL), 0.1),
        'b_q_norm': gain((N_B_LAYERS, HEAD_DIM)),
        'b_k_norm': gain((N_B_LAYERS, HEAD_DIM)),
        'b_lambda_q1': nrm((N_B_LAYERS, HEAD_DIM), 0.1),
        'b_lambda_k1': nrm((N_B_LAYERS, HEAD_DIM), 0.1),
        'b_lambda_q2': nrm((N_B_LAYERS, HEAD_DIM), 0.1),
        'b_lambda_k2': nrm((N_B_LAYERS, HEAD_DIM), 0.1),
        'b_subln': gain((N_B_LAYERS, 2 * HEAD_DIM)),
        'ffn2_norm': gain((DEPTH, D_MODEL)),
        'ffn2_w_gate': nrm((DEPTH, D_MODEL, D_FF), D_MODEL ** -0.5),
        'ffn2_w_up': nrm((DEPTH, D_MODEL, D_FF), D_MODEL ** -0.5),
        'ffn2_w_down': nrm((DEPTH, D_FF, D_MODEL), D_FF ** -0.5),
    }


def reference(x, mem, positions, ffn1_norm, ffn1_w_gate, ffn1_w_up, ffn1_w_down,
              mix_norm, mem_norm, w_in, w_mem_kv, mem_q_norm, mem_k_norm, w_out,
              a_q_norm, a_k_norm, a_rel_bias, b_q_norm, b_k_norm,
              b_lambda_q1, b_lambda_k1, b_lambda_q2, b_lambda_k2, b_subln,
              ffn2_norm, ffn2_w_gate, ffn2_w_up, ffn2_w_down):
    B, S, _ = x.shape
    cos, sin = rope_tables(positions)
    cos = cos[:, :, None, None, :]
    sin = sin[:, :, None, None, :]

    for i in range(DEPTH):
        h = rmsnorm(x, ffn1_norm[i])
        x = x + 0.5 * swiglu(h, ffn1_w_gate[i], ffn1_w_up[i], ffn1_w_down[i])

        h = rmsnorm(x, mix_norm[i])
        proj = h @ w_in[i]
        q_s, k_s, v_s, q_m = jnp.split(proj, [SELF_WIDTH, 2 * SELF_WIDTH, 3 * SELF_WIDTH], axis=-1)

        mkv = rmsnorm(mem, mem_norm[i]) @ w_mem_kv[i]
        k_m, v_m = jnp.split(mkv, 2, axis=-1)
        q_m = rmsnorm(q_m.reshape(B, S, N_MEM_HEADS, HEAD_DIM), mem_q_norm[i])
        k_m = rmsnorm(k_m.reshape(B, N_MEM, N_MEM_HEADS, HEAD_DIM), mem_k_norm[i])
        v_m = v_m.reshape(B, N_MEM, N_MEM_HEADS, HEAD_DIM)
        o_m = memory_attention(q_m, k_m, v_m).reshape(B, S, MEM_WIDTH)

        j = i // N_MIXERS
        if i % N_MIXERS == 0:
            q = rmsnorm(q_s.reshape(B, S, N_SELF_HEADS, HEAD_DIM), a_q_norm[j])
            k = rmsnorm(k_s.reshape(B, S, N_SELF_HEADS, HEAD_DIM), a_k_norm[j])
            v = v_s.reshape(B, S, N_SELF_HEADS, HEAD_DIM)
            o_s = chunked_rel_attention(q, k, v, a_rel_bias[j]).reshape(B, S, SELF_WIDTH)
        else:
            lambda_init = 0.8 - 0.6 * math.exp(-0.3 * i)
            q = rmsnorm(q_s.reshape(B, S, N_DIFF_HEADS, 2, HEAD_DIM), b_q_norm[j])
            k = rmsnorm(k_s.reshape(B, S, N_DIFF_HEADS, 2, HEAD_DIM), b_k_norm[j])
            q = apply_rope(q, cos, sin)
            k = apply_rope(k, cos, sin)
            v = v_s.reshape(B, S, N_DIFF_HEADS, 2 * HEAD_DIM)
            lam = (jnp.exp(jnp.sum(b_lambda_q1[j].astype(jnp.float32) * b_lambda_k1[j].astype(jnp.float32)))
                   - jnp.exp(jnp.sum(b_lambda_q2[j].astype(jnp.float32) * b_lambda_k2[j].astype(jnp.float32)))
                   + lambda_init)
            o = diff_attention(q, k, v, lam)
            o = rmsnorm(o, b_subln[j]) * (1.0 - lambda_init)
            o_s = o.reshape(B, S, SELF_WIDTH)

        x = x + jnp.concatenate([o_s, o_m], axis=-1) @ w_out[i]

        h = rmsnorm(x, ffn2_norm[i])
        x = x + 0.5 * swiglu(h, ffn2_w_gate[i], ffn2_w_up[i], ffn2_w_down[i])
    return x
```

```cpp
#include <hip/hip_runtime.h>
#include <hip/hip_cooperative_groups.h>
#include <cstdio>
#include <cstdint>
namespace cg = cooperative_groups;

namespace pg8 {
#define PG8_LAS __attribute__((address_space(3)))
typedef unsigned short bf16_t;
typedef short bf16x8 __attribute__((ext_vector_type(8)));
typedef float f32x4 __attribute__((ext_vector_type(4)));
typedef unsigned u32x4 __attribute__((ext_vector_type(4)));
constexpr int BM = 256, BK = 64, HALF = 128, HTB = HALF * BK * 2  , STAGE_BYTES = 8 * HTB, NXCD = 8, WGM = 8;

__host__ __device__ __forceinline__ int lds_byte(int r, int c) { const int st = (r >> 4) * 2 + (c >> 5), rr = r & 15, cc = c & 31, ob = rr * 64 + cc * 2; return st * 1024 + (ob ^ (((ob >> 9) & 1) << 5)); }
__host__ __device__ __forceinline__ void stage_rc(int b, int& R, int& C) { const int st = b / 1024, sb = b % 1024, swz = sb ^ (((sb >> 9) & 1) << 5); R = (st >> 1) * 16 + swz / 64; C = (st & 1) * 32 + (swz % 64) / 2; }
__host__ __device__ __forceinline__ int perm32(int rho) { const int n = rho >> 4, i = rho & 15; return 8 * (i >> 2) + 4 * n + (i & 3); }

struct Unit { int pm, pn; };
struct Gemm { const bf16_t* A; const bf16_t* Bt; int M, N, K; };

struct StaticOrder {
    int nM, nN, nwg, G, c;
    __host__ __device__ void init(int M, int N, int G_, int c_) { nM = M / BM; nN = N / BM; nwg = nM * nN; G = G_; c = c_; }
    __host__ __device__ bool next(int i, Unit& u) const {
        const long L = (long)i * G + c; if (L >= nwg) return false;
        int wgid = (int)L; { const int q = nwg / NXCD, r = nwg % NXCD, xcd = wgid % NXCD, off = wgid / NXCD; wgid = (xcd < r ? xcd * (q + 1) : r * (q + 1) + (xcd - r) * q) + off; }
        const int nig = WGM * nN, gid = wgid / nig, fm = gid * WGM, gsz = (nM - fm) < WGM ? (nM - fm) : WGM;
        u.pm = fm + ((wgid % nig) % gsz); u.pn = (wgid % nig) / gsz; return true;
    }
    __device__ __forceinline__ void a_ready(const Unit&) const {}
    __device__ __forceinline__ void done(const Unit&) const {}
};


__device__ __forceinline__ unsigned cvt_pk_bf16(float lo, float hi) { unsigned r; asm volatile("v_cvt_pk_bf16_f32 %0, %1, %2" : "=v"(r) : "v"(lo), "v"(hi)); return r; }
typedef float f32x2 __attribute__((ext_vector_type(2)));


#define PG8_GAS __attribute__((address_space(1)))
constexpr float RMS_EPS = 1e-6f;
constexpr float QK_C2 = 0.125f * 1.4426950408889634f;
__device__ __forceinline__ float fast_silu(float g) { return g * __builtin_amdgcn_rcpf(1.0f + __builtin_amdgcn_exp2f(-1.4426950408889634f * g)); }


struct OpDesc {
    int type, M, N, K;
    const bf16_t* A; const bf16_t* Bt;
    const void* p[10];
    float f[2]; int i[2];
};
static_assert(sizeof(OpDesc) == 128, "OpDesc");

__device__ __forceinline__ void row_rstd8(const PG8_GAS float* ssp, int row0, int fq, float (&rstd)[8]) {
    f32x4 t[8];
#pragma unroll
    for (int i = 0; i < 8; ++i) t[i] = *(const PG8_GAS f32x4*)(ssp + (size_t)(row0 + (i >> 2) * HALF + (i & 3) * 16) * 16 + 4 * fq);
#pragma unroll
    for (int i = 0; i < 8; ++i) { float s = (t[i][0] + t[i][1]) + (t[i][2] + t[i][3]); s += __shfl_xor(s, 16); s += __shfl_xor(s, 32); rstd[i] = rsqrtf(s * (1.0f / 1024.0f) + RMS_EPS); }
}

__device__ __forceinline__ void row_ms8(const PG8_GAS float* ssp, int row0, int fq, float (&ms)[8]) {
    f32x4 t[8];
#pragma unroll
    for (int i = 0; i < 8; ++i) t[i] = *(const PG8_GAS f32x4*)(ssp + (size_t)(row0 + (i >> 2) * HALF + (i & 3) * 16) * 16 + 4 * fq);
#pragma unroll
    for (int i = 0; i < 8; ++i) { float s = (t[i][0] + t[i][1]) + (t[i][2] + t[i][3]); s += __shfl_xor(s, 16); s += __shfl_xor(s, 32); ms[i] = s * (1.0f / 1024.0f) + RMS_EPS; }
}

struct EpiCtx { int ui; PG8_LAS unsigned char* lds; int tid; };
constexpr int STAT_OFF = STAGE_BYTES + 1024;

struct EpiGateUp {
    static constexpr bool PERM = true, AFTER_DRAIN = false;
    const OpDesc* d;
    __device__ __forceinline__ void operator()(const f32x4 (&acc)[2][2][4][2], const Unit& u, int wr, int wc, int fr, int fq, const EpiCtx& c) const {
        PG8_GAS bf16_t* H = (PG8_GAS bf16_t*)d->p[0]; const PG8_GAS float* ss = (const PG8_GAS float*)d->p[1]; const int ldh = 2816;
        const int row0 = u.pm * BM + wr * 64 + fr, col0 = u.pn * HALF + wc * 32 + 8 * fq;
        float ms8[8];
        PG8_LAS float* slot = (PG8_LAS float*)(c.lds + STAT_OFF) + c.tid;
        PG8_LAS int* pmslot = (PG8_LAS int*)(slot + 8 * 512);
        if (c.ui == 0 || pmslot[0] != u.pm) { row_ms8(ss, row0, fq, ms8); pmslot[0] = u.pm;
#pragma unroll
            for (int i = 0; i < 8; ++i) slot[i * 512] = ms8[i]; }
        else {
#pragma unroll
            for (int i = 0; i < 8; ++i) ms8[i] = slot[i * 512];
        }
#pragma unroll
        for (int ai = 0; ai < 2; ++ai)
#pragma unroll
            for (int m = 0; m < 4; ++m) {
                const int row = row0 + ai * HALF + m * 16;
                const float ms = ms8[ai * 4 + m], c = -1.4426950408889634f * rsqrtf(ms);
                float hv[8];
#pragma unroll
                for (int n = 0; n < 2; ++n)
#pragma unroll
                    for (int jp = 0; jp < 2; ++jp) {
                        const f32x2 g = (f32x2){acc[ai][0][m][n][2 * jp], acc[ai][0][m][n][2 * jp + 1]}, uu = (f32x2){acc[ai][1][m][n][2 * jp], acc[ai][1][m][n][2 * jp + 1]};
                        const f32x2 t = g * c; f32x2 ee; ee.x = __builtin_amdgcn_exp2f(t.x); ee.y = __builtin_amdgcn_exp2f(t.y);
                        const f32x2 dd = ee * ms + ms; f32x2 sg; sg.x = __builtin_amdgcn_rcpf(dd.x); sg.y = __builtin_amdgcn_rcpf(dd.y);
                        const f32x2 h = (g * uu) * sg;
                        hv[4 * n + 2 * jp] = h.x; hv[4 * n + 2 * jp + 1] = h.y; }
                u32x4 w; w.x = cvt_pk_bf16(hv[0], hv[1]); w.y = cvt_pk_bf16(hv[2], hv[3]); w.z = cvt_pk_bf16(hv[4], hv[5]); w.w = cvt_pk_bf16(hv[6], hv[7]);
                *(PG8_GAS u32x4*)(H + (size_t)row * ldh + col0) = w;
            }
    }
};

__device__ __forceinline__ float bf_lo(unsigned w) { return __builtin_bit_cast(float, w << 16); }
__device__ __forceinline__ float bf_hi(unsigned w) { return __builtin_bit_cast(float, w & 0xffff0000u); }
typedef unsigned u32x2 __attribute__((ext_vector_type(2)));
struct EpiResid {
    static constexpr bool PERM = true, AFTER_DRAIN = false;
    const OpDesc* d; float smul;
    __device__ __forceinline__ void operator()(const f32x4 (&acc)[2][2][4][2], const Unit& u, int wr, int wc, int fr, int fq, const EpiCtx&) const {
        PG8_GAS unsigned char* XL = (PG8_GAS unsigned char*)d->p[0]; PG8_GAS bf16_t* XB = (PG8_GAS bf16_t*)d->p[1]; PG8_GAS float* ssn = (PG8_GAS float*)d->p[2]; PG8_GAS float* OUT = (PG8_GAS float*)d->p[3];
        const float scale = d->f[0] * smul; const bool last = d->i[0] != 0;
        const int row0 = u.pm * BM + wr * 64 + fr, col0 = u.pn * BM + wc * 32 + 8 * fq;
        u32x4 hv[3][2]; u32x2 lv[3][2];
#define RES_LOAD(set, k_) do { const size_t o_ = (size_t)(row0 + ((k_) >> 2) * HALF + ((k_) & 3) * 16) * 1024 + col0; \
            _Pragma("unroll") for (int bj = 0; bj < 2; ++bj) { hv[set][bj] = *(const PG8_GAS u32x4*)(XB + o_ + bj * HALF); lv[set][bj] = *(const PG8_GAS u32x2*)(XL + o_ + bj * HALF); } } while (0)
        RES_LOAD(0, 0); RES_LOAD(1, 1);
#pragma unroll
        for (int k = 0; k < 8; ++k) {
            const int ai = k >> 2, m = k & 3, cur = k % 3;
            if (k + 2 < 8) RES_LOAD((k + 2) % 3, k + 2);
            const int row = row0 + ai * HALF + m * 16;
            const size_t o_ = (size_t)row * 1024 + col0;
            float sq = 0.f;
#pragma unroll
            for (int bj = 0; bj < 2; ++bj) {
                float x[8];
                const f32x2 l01 = __builtin_amdgcn_cvt_pk_f32_fp8(lv[cur][bj][0], false), l23 = __builtin_amdgcn_cvt_pk_f32_fp8(lv[cur][bj][0], true);
                const f32x2 l45 = __builtin_amdgcn_cvt_pk_f32_fp8(lv[cur][bj][1], false), l67 = __builtin_amdgcn_cvt_pk_f32_fp8(lv[cur][bj][1], true);
                const float lo8[8] = {l01[0], l01[1], l23[0], l23[1], l45[0], l45[1], l67[0], l67[1]};
#pragma unroll
                for (int q = 0; q < 4; ++q) {
                    x[2 * q] = (bf_lo(hv[cur][bj][q]) + lo8[2 * q] * (1.0f / 1024.0f)) + acc[ai][bj][m][q >> 1][(2 * q) & 3] * scale;
                    x[2 * q + 1] = (bf_hi(hv[cur][bj][q]) + lo8[2 * q + 1] * (1.0f / 1024.0f)) + acc[ai][bj][m][q >> 1][(2 * q + 1) & 3] * scale;
                }
#pragma unroll
                for (int q = 0; q < 8; ++q) sq += x[q] * x[q];
                if (last) {
                    *(PG8_GAS f32x4*)(OUT + o_ + bj * HALF) = (f32x4){x[0], x[1], x[2], x[3]}; *(PG8_GAS f32x4*)(OUT + o_ + bj * HALF + 4) = (f32x4){x[4], x[5], x[6], x[7]};
                } else {
                    u32x4 h; u32x2 l; float rr[8];
#pragma unroll
                    for (int q = 0; q < 4; ++q) { const unsigned hw = cvt_pk_bf16(x[2 * q], x[2 * q + 1]); h[q] = hw; rr[2 * q] = __builtin_amdgcn_fmed3f((x[2 * q] - bf_lo(hw)) * 1024.0f, -448.0f, 448.0f); rr[2 * q + 1] = __builtin_amdgcn_fmed3f((x[2 * q + 1] - bf_hi(hw)) * 1024.0f, -448.0f, 448.0f); }
                    l[0] = __builtin_amdgcn_cvt_pk_fp8_f32(rr[0], rr[1], 0u, false); l[0] = __builtin_amdgcn_cvt_pk_fp8_f32(rr[2], rr[3], l[0], true);
                    l[1] = __builtin_amdgcn_cvt_pk_fp8_f32(rr[4], rr[5], 0u, false); l[1] = __builtin_amdgcn_cvt_pk_fp8_f32(rr[6], rr[7], l[1], true);
                    *(PG8_GAS u32x4*)(XB + o_ + bj * HALF) = h; *(PG8_GAS u32x2*)(XL + o_ + bj * HALF) = l;
                }
            }
            sq += __shfl_xor(sq, 16); sq += __shfl_xor(sq, 32);
            if (fq == 0) ssn[(size_t)row * 16 + u.pn * 4 + wc] = sq;
        }
#undef RES_LOAD
    }
};

struct EpiProj {
    static constexpr bool PERM = true, AFTER_DRAIN = false;
    const OpDesc* d;
    __device__ __forceinline__ void operator()(const f32x4 (&acc)[2][2][4][2], const Unit& u, int wr, int wc, int fr, int fq, const EpiCtx& c) const {
        const int fl = d->i[0]; const int stat_is_ss = fl & 1, memmode = (fl >> 1) & 1, rope = (fl >> 2) & 1;
        int kind, tcol, ld;
        if (memmode) { kind = (u.pn == 0) ? 1 : 2; tcol = 0; ld = 256; }
        else { kind = u.pn < 3 ? 0 : (u.pn < 6 ? 1 : (u.pn < 9 ? 2 : 3)); tcol = (u.pn - 3 * kind) * 256; ld = (kind == 3) ? 256 : 768; }
        PG8_GAS bf16_t* out = (PG8_GAS bf16_t*)d->p[1 + kind];
        const PG8_GAS float* gp = (kind == 2) ? nullptr : (const PG8_GAS float*)d->p[kind == 3 ? 7 : 5 + kind];
        const PG8_GAS float* rowstat = (const PG8_GAS float*)d->p[0]; const PG8_GAS float* cosT = (const PG8_GAS float*)d->p[8]; const PG8_GAS float* sinT = (const PG8_GAS float*)d->p[9];
        const float sc = (kind == 0 || kind == 3) ? QK_C2 : 1.0f;
        const bool dorope = rope && kind < 2 && !memmode;
        f32x4 gv[2][2];
#pragma unroll
        for (int bj = 0; bj < 2; ++bj)
#pragma unroll
            for (int n = 0; n < 2; ++n) gv[bj][n] = gp ? *(const PG8_GAS f32x4*)(gp + 32 * bj + 8 * fq + 4 * n) : (f32x4){1.f, 1.f, 1.f, 1.f};
        const int row0 = u.pm * BM + wr * 64 + fr;
        float rstd8[8];
        PG8_LAS float* slot = (PG8_LAS float*)(c.lds + STAT_OFF) + c.tid;
        PG8_LAS int* pmslot = (PG8_LAS int*)(slot + 8 * 512);
        if (stat_is_ss && c.ui != 0 && pmslot[0] == u.pm) {
#pragma unroll
            for (int i = 0; i < 8; ++i) rstd8[i] = slot[i * 512];
        } else if (stat_is_ss) { row_rstd8(rowstat, row0, fq, rstd8); pmslot[0] = u.pm;
#pragma unroll
            for (int i = 0; i < 8; ++i) slot[i * 512] = rstd8[i]; }
        else {
#pragma unroll
            for (int i = 0; i < 8; ++i) rstd8[i] = rowstat[row0 + (i >> 2) * HALF + (i & 3) * 16];
        }
#pragma unroll
        for (int am = 0; am < 4; ++am) {
            const int ai = am >> 1;
            f32x4 cv[2][2], sv[2][2];
            if (dorope) {
#pragma unroll
                for (int m2 = 0; m2 < 2; ++m2)
#pragma unroll
                    for (int n = 0; n < 2; ++n) { const size_t o_ = (size_t)(row0 + ai * HALF + ((am & 1) * 2 + m2) * 16) * 32 + 8 * fq + 4 * n; cv[m2][n] = *(const PG8_GAS f32x4*)(cosT + o_); sv[m2][n] = *(const PG8_GAS f32x4*)(sinT + o_); }
            }
#pragma unroll
            for (int m2 = 0; m2 < 2; ++m2) {
                const int m = (am & 1) * 2 + m2;
                const int row = row0 + ai * HALF + m * 16;
                const float rs = rstd8[ai * 4 + m];
                f32x4 v[2][2];
#pragma unroll
                for (int bj = 0; bj < 2; ++bj)
#pragma unroll
                    for (int n = 0; n < 2; ++n) v[bj][n] = acc[ai][bj][m][n] * rs;
                if (gp) {
                    float sq = 0.f;
#pragma unroll
                    for (int bj = 0; bj < 2; ++bj)
#pragma unroll
                        for (int n = 0; n < 2; ++n) sq += (v[bj][n][0] * v[bj][n][0] + v[bj][n][1] * v[bj][n][1]) + (v[bj][n][2] * v[bj][n][2] + v[bj][n][3] * v[bj][n][3]);
                    sq += __shfl_xor(sq, 16); sq += __shfl_xor(sq, 32);
                    const float hr = rsqrtf(sq * (1.0f / 64.0f) + RMS_EPS);
#pragma unroll
                    for (int bj = 0; bj < 2; ++bj)
#pragma unroll
                        for (int n = 0; n < 2; ++n) v[bj][n] = v[bj][n] * hr * gv[bj][n];
                    if (dorope) {
#pragma unroll
                        for (int n = 0; n < 2; ++n) {
                            const f32x4 c = cv[m2][n], s = sv[m2][n];
                            const f32x4 x1 = v[0][n], x2 = v[1][n];
                            v[0][n] = x1 * c - x2 * s; v[1][n] = x2 * c + x1 * s;
                        }
                    }
#pragma unroll
                    for (int bj = 0; bj < 2; ++bj)
#pragma unroll
                        for (int n = 0; n < 2; ++n) v[bj][n] = v[bj][n] * sc;
                }
                PG8_GAS bf16_t* op = out + (size_t)row * ld + tcol + 64 * wc + 8 * fq;
#pragma unroll
                for (int bj = 0; bj < 2; ++bj) {
                    u32x4 w; w.x = cvt_pk_bf16(v[bj][0][0], v[bj][0][1]); w.y = cvt_pk_bf16(v[bj][0][2], v[bj][0][3]); w.z = cvt_pk_bf16(v[bj][1][0], v[bj][1][1]); w.w = cvt_pk_bf16(v[bj][1][2], v[bj][1][3]);
                    *(PG8_GAS u32x4*)(op + 32 * bj) = w;
                }
            }
        }
    }
};

template <class Epi, class Sched, bool ALIGN_EPI = false, bool SP2 = false>
__device__ __forceinline__ void gemm_phase(PG8_LAS unsigned char* lds, const Gemm g, const Sched& S, const Epi& E) {
    int tid_ = threadIdx.x; asm volatile("" : "+v"(tid_));
    const int tid = tid_, wid = __builtin_amdgcn_readfirstlane(tid >> 6), lane = tid & 63, wr = wid >> 2, wc = wid & 3, fr = lane & 15, fq = lane >> 4;
    const int K = g.K, nt = K / BK;
    unsigned voffA[2], voffB[2];
#pragma unroll
    for (int i = 0; i < 2; ++i) { int R, C; stage_rc(tid * 16 + i * 8192, R, C); const int Rb = Epi::PERM ? ((R & ~31) + perm32(R & 31)) : R;
        voffA[i] = (unsigned)(R * K + C) * 2u; voffB[i] = (unsigned)(Rb * K + C) * 2u; }
    const size_t kstep = (size_t)(BK * 2);
    const size_t hstep = (size_t)HALF * K * 2;
    const size_t tstep = 2 * hstep;
    const unsigned ldsw = (unsigned)wid * 1024u;
    const int aoff = lds_byte(wr * 64 + fr, fq * 8), boff = lds_byte(wc * 32 + fr, fq * 8);
#define PG8_SA(b, h) (((b) * 2 + (h)) * HTB)
#define PG8_SB(b, h) ((4 + (b) * 2 + (h)) * HTB)
#define PG8_STAGE(bufoff, gbase, voff) do { _Pragma("unroll") for (int _i = 0; _i < 2; ++_i) \
        __builtin_amdgcn_global_load_lds((const unsigned*)((const char*)(gbase) + (voff)[_i]), (PG8_LAS unsigned*)(lds + (bufoff) + ldsw + _i * 8192), 16, 0, 0); } while (0)
#define PG8_LDA(dst, b, h) do { _Pragma("unroll") for (int m = 0; m < 4; ++m) _Pragma("unroll") for (int k = 0; k < 2; ++k) dst[m][k] = *(const PG8_LAS bf16x8*)(lds + PG8_SA(b, h) + aoff + m * 2048 + k * 1024); } while (0)
#define PG8_LDB(dst, b, h) do { _Pragma("unroll") for (int n = 0; n < 2; ++n) _Pragma("unroll") for (int k = 0; k < 2; ++k) dst[n][k] = *(const PG8_LAS bf16x8*)(lds + PG8_SB(b, h) + boff + n * 2048 + k * 1024); } while (0)
#define PG8_MMA(ai, bj, At, Bt) do { __builtin_amdgcn_s_setprio(1); _Pragma("unroll") for (int m = 0; m < 4; ++m) _Pragma("unroll") for (int n = 0; n < 2; ++n) _Pragma("unroll") for (int k = 0; k < 2; ++k) \
        acc[ai][bj][m][n] = __builtin_amdgcn_mfma_f32_16x16x32_bf16(Bt[n][k], At[m][k], acc[ai][bj][m][n], 0, 0, 0); __builtin_amdgcn_s_setprio(0); } while (0)
#define PG8_WAIT_V(n) asm volatile("s_waitcnt vmcnt(" #n ")" ::: "memory")
#define PG8_WAIT_L(n) asm volatile("s_waitcnt lgkmcnt(" #n ")" ::: "memory")
#define PG8_BAR __builtin_amdgcn_s_barrier()
#define PG8_SCHED __builtin_amdgcn_sched_barrier(0)
    Unit cur, nxt; int ui = 0;
    if (!S.next(0, cur)) return;
    f32x4 acc[2][2][4][2];
#pragma unroll
    for (int a = 0; a < 2; ++a)
#pragma unroll
        for (int b = 0; b < 2; ++b)
#pragma unroll
            for (int m = 0; m < 4; ++m)
#pragma unroll
                for (int n = 0; n < 2; ++n) acc[a][b][m][n] = (f32x4){0.f, 0.f, 0.f, 0.f};
    bf16x8 At[4][2], B0[2][2], B1[2][2];
    const char* cA = (const char*)g.A + (size_t)cur.pm * tstep; const char* cB = (const char*)g.Bt + (size_t)cur.pn * tstep;
    S.a_ready(cur);
    if constexpr (SP2) {
        PG8_STAGE(PG8_SB(0, 0), cB, voffB); PG8_STAGE(PG8_SB(0, 1), cB + hstep, voffB); PG8_STAGE(PG8_SA(0, 0), cA, voffA); PG8_STAGE(PG8_SA(0, 1), cA + hstep, voffA);
        if (wr == 1) PG8_BAR;
        PG8_WAIT_V(2); PG8_BAR;
        PG8_STAGE(PG8_SB(1, 0), cB + kstep, voffB); PG8_STAGE(PG8_SA(1, 0), cA + kstep, voffA); PG8_STAGE(PG8_SB(1, 1), cB + hstep + kstep, voffB);
        PG8_WAIT_V(6); PG8_BAR;
    } else {
        PG8_STAGE(PG8_SB(0, 0), cB, voffB); PG8_STAGE(PG8_SA(0, 0), cA, voffA); PG8_STAGE(PG8_SB(0, 1), cB + hstep, voffB); PG8_STAGE(PG8_SA(0, 1), cA + hstep, voffA);
        if (wr == 1) PG8_BAR;
        PG8_WAIT_V(4); PG8_BAR;
        PG8_STAGE(PG8_SB(1, 0), cB + kstep, voffB); PG8_STAGE(PG8_SA(1, 0), cA + kstep, voffA); PG8_STAGE(PG8_SB(1, 1), cB + hstep + kstep, voffB);
        PG8_WAIT_V(6); PG8_BAR;
    }
    for (;;) {
        const bool has_next = S.next(ui + 1, nxt);
        const char* nA = has_next ? (const char*)g.A + (size_t)nxt.pm * tstep : cA; const char* nB = has_next ? (const char*)g.Bt + (size_t)nxt.pn * tstep : cB;
        for (int t = 0; t < nt; t += 2) {
            const bool last = (t == nt - 2);
            const char* a1 = cA + (size_t)(t + 1) * kstep;
            const char* a2 = last ? nA : cA + (size_t)(t + 2) * kstep; const char* b2 = last ? nB : cB + (size_t)(t + 2) * kstep;
            const char* a3 = a2 + kstep; const char* b3 = b2 + kstep;
            if (last && has_next) S.a_ready(nxt);
            if constexpr (SP2) {
            PG8_LDB(B0, 0, 0); PG8_LDB(B1, 0, 1); PG8_SCHED; PG8_LDA(At, 0, 0); PG8_STAGE(PG8_SA(1, 1), a1 + hstep, voffA);
            PG8_WAIT_V(8); PG8_WAIT_L(0); PG8_BAR; PG8_MMA(0, 0, At, B0); PG8_MMA(0, 1, At, B1); PG8_BAR; PG8_SCHED;
            PG8_LDA(At, 0, 1); PG8_STAGE(PG8_SB(0, 0), b2, voffB); PG8_STAGE(PG8_SB(0, 1), b2 + hstep, voffB); PG8_STAGE(PG8_SA(0, 0), a2, voffA);
            PG8_WAIT_V(8); PG8_WAIT_L(0); PG8_BAR; PG8_MMA(1, 0, At, B0); PG8_MMA(1, 1, At, B1); PG8_BAR; PG8_SCHED;
            PG8_LDB(B0, 1, 0); PG8_LDB(B1, 1, 1); PG8_SCHED; PG8_LDA(At, 1, 0); PG8_STAGE(PG8_SA(0, 1), a2 + hstep, voffA);
            PG8_WAIT_V(8); PG8_WAIT_L(0); PG8_BAR; PG8_MMA(0, 0, At, B0); PG8_MMA(0, 1, At, B1); PG8_BAR; PG8_SCHED;
            PG8_LDA(At, 1, 1); PG8_STAGE(PG8_SB(1, 0), b3, voffB); PG8_STAGE(PG8_SB(1, 1), b3 + hstep, voffB); PG8_STAGE(PG8_SA(1, 0), a3, voffA);
            PG8_WAIT_V(8); PG8_WAIT_L(0); PG8_BAR; PG8_MMA(1, 0, At, B0); PG8_MMA(1, 1, At, B1); PG8_BAR; PG8_SCHED;
            } else {
            PG8_LDB(B0, 0, 0); PG8_SCHED; PG8_LDA(At, 0, 0); PG8_STAGE(PG8_SA(1, 1), a1 + hstep, voffA);
            PG8_WAIT_L(8); PG8_BAR; PG8_WAIT_L(0); PG8_MMA(0, 0, At, B0); PG8_BAR; PG8_SCHED;
            PG8_LDB(B1, 0, 1); PG8_STAGE(PG8_SB(0, 0), b2, voffB);
            PG8_BAR; PG8_WAIT_L(0); PG8_MMA(0, 1, At, B1); PG8_BAR;
            PG8_LDA(At, 0, 1); PG8_STAGE(PG8_SA(0, 0), a2, voffA);
            PG8_BAR; PG8_WAIT_L(0); PG8_MMA(1, 0, At, B0); PG8_BAR; PG8_SCHED;
            PG8_STAGE(PG8_SB(0, 1), b2 + hstep, voffB);
            PG8_WAIT_V(6); PG8_BAR; PG8_MMA(1, 1, At, B1); PG8_BAR;
            PG8_LDB(B0, 1, 0); PG8_SCHED; PG8_LDA(At, 1, 0); PG8_STAGE(PG8_SA(0, 1), a2 + hstep, voffA);
            PG8_WAIT_L(8); PG8_BAR; PG8_WAIT_L(0); PG8_MMA(0, 0, At, B0); PG8_BAR; PG8_SCHED;
            PG8_LDB(B1, 1, 1); PG8_STAGE(PG8_SB(1, 0), b3, voffB);
            PG8_BAR; PG8_WAIT_L(0); PG8_MMA(0, 1, At, B1); PG8_BAR;
            PG8_LDA(At, 1, 1); PG8_STAGE(PG8_SA(1, 0), a3, voffA);
            PG8_BAR; PG8_WAIT_L(0); PG8_MMA(1, 0, At, B0); PG8_BAR; PG8_SCHED;
            PG8_STAGE(PG8_SB(1, 1), b3 + hstep, voffB);
            PG8_WAIT_V(6); PG8_BAR; PG8_MMA(1, 1, At, B1); PG8_BAR;
            }
        }
        if constexpr (ALIGN_EPI) { if (wr == 0) PG8_BAR; }
        if constexpr (!Epi::AFTER_DRAIN) { const EpiCtx ctx{ui, lds, tid}; E(acc, cur, wr, wc, fr, fq, ctx); S.done(cur); }
        if (!has_next) break;
#pragma unroll
        for (int a = 0; a < 2; ++a)
#pragma unroll
            for (int b = 0; b < 2; ++b)
#pragma unroll
                for (int m = 0; m < 4; ++m)
#pragma unroll
                    for (int n = 0; n < 2; ++n) acc[a][b][m][n] = (f32x4){0.f, 0.f, 0.f, 0.f};
        cur = nxt; cA = nA; cB = nB; ++ui;
        if constexpr (ALIGN_EPI) { if (wr == 1) PG8_BAR; }
    }
    PG8_WAIT_V(0);
    if constexpr (!ALIGN_EPI) { if (wr == 0) PG8_BAR; }
    PG8_BAR;
    if constexpr (Epi::AFTER_DRAIN) { E.fused(acc, cur, wr, wc, fr, fq, lds, wid, lane); S.done(cur); }
#undef PG8_SA
#undef PG8_SB
#undef PG8_STAGE
#undef PG8_LDA
#undef PG8_LDB
#undef PG8_MMA
#undef PG8_WAIT_V
#undef PG8_WAIT_L
#undef PG8_BAR
#undef PG8_SCHED
}
}


namespace att {
#define ATT_LAS __attribute__((address_space(3)))
#define ATT_GAS __attribute__((address_space(1)))
typedef unsigned short bf16_t;
typedef short bf16x8 __attribute__((ext_vector_type(8)));
typedef short s16x4 __attribute__((ext_vector_type(4)));
typedef float f32x16 __attribute__((ext_vector_type(16)));
typedef float f32x4 __attribute__((ext_vector_type(4)));
typedef unsigned u32x4 __attribute__((ext_vector_type(4)));
typedef unsigned u32x2 __attribute__((ext_vector_type(2)));
typedef float f32x2_t __attribute__((ext_vector_type(2))); typedef __bf16 bf16x2_t __attribute__((ext_vector_type(2)));
__device__ __forceinline__ unsigned cvtpk(float lo, float hi) { f32x2_t v = {lo, hi}; bf16x2_t b = __builtin_convertvector(v, bf16x2_t); return __builtin_bit_cast(unsigned, b); }
__device__ __forceinline__ s16x4 vtr(const ATT_LAS char* p) { return __builtin_bit_cast(s16x4, __builtin_amdgcn_ds_read_tr16_b64_v4i16((ATT_LAS s16x4*)p)); }
__device__ __forceinline__ float max3f(float x, float y, float z) { float r; asm("v_max3_f32 %0, %1, %2, %3" : "=v"(r) : "v"(x), "v"(y), "v"(z)); return r; }
__device__ __forceinline__ int crow(int r, int hi) { return (r & 3) + 8 * (r >> 2) + 4 * hi; }

constexpr int KSTR = 144, KSUB = 64 * KSTR, KBUF = 2 * KSUB;
constexpr int VBUF = 64 * 320;
constexpr int L_K = 0, L_V = 2 * KBUF, L_BIAS = L_V + 3 * VBUF, L_MISC = L_BIAS + 1056, L_Q = L_MISC + 64, L_END = L_Q + 8 * 4096;
constexpr float LOG2E = 1.4426950408889634f;
constexpr float RMS_EPS = 1e-6f;

struct Args {
    const ATT_GAS bf16_t *Qs, *Ks, *Vs, *Qm, *memK, *memV; ATT_GAS bf16_t* Ocat;
    const ATT_GAS float* relb;
    const ATT_GAS float* subln;
    float lam, one_m_li;
};

template <int KIND> __device__ __forceinline__ void attn_unit(ATT_LAS char* lds, const Args& a, int u, ATT_GAS unsigned* ctr, int& nxt) {
    constexpr int DV = (KIND == 1) ? 128 : 64, NDB = DV / 32, NC = (KIND == 1) ? 2 : 1, VSTR = (KIND == 1) ? 320 : 192;
    int tid_ = threadIdx.x; asm volatile("" : "+v"(tid_));
    const int tid = tid_, lane = tid & 63, r32 = lane & 31, hi = lane >> 5; const int wid = __builtin_amdgcn_readfirstlane(tid >> 6);
    int t_lo, t_hi, my_lo, my_hi, wchunk = 0, map = 0, qrow, ocol, kld, h;
    const ATT_GAS bf16_t *Qp, *Kp, *Vp;
    if (KIND == 0) {
        const int b = u / 192; h = (u >> 4) % 12; const int c0 = (u & 15) * 4;
        wchunk = c0 + (wid >> 1); qrow = b * 4096 + wchunk * 64 + (wid & 1) * 32;
        t_lo = c0 - 8 < 0 ? 0 : c0 - 8; t_hi = c0 + 3; my_lo = wchunk - 8 < 0 ? 0 : wchunk - 8; my_hi = wchunk;
        kld = 768; Qp = a.Qs + (size_t)qrow * 768 + h * 64; Kp = a.Ks + (size_t)b * 4096 * 768 + h * 64; Vp = a.Vs + (size_t)b * 4096 * 768 + h * 64; ocol = h * 64;
    } else if (KIND == 1) {
        const int qb = 31 - u / 24, bh = u % 24, b = bh / 6; h = bh % 6; const int c0 = 2 * qb, wq = wid & 3; map = wid >> 2;
        wchunk = c0 + (wq >> 1); qrow = b * 4096 + qb * 128 + wq * 32;
        t_lo = 0; t_hi = c0 + 1; my_lo = 0; my_hi = wchunk;
        kld = 768; Qp = a.Qs + (size_t)qrow * 768 + (h * 2 + map) * 64; Kp = a.Ks + (size_t)b * 4096 * 768 + h * 128; Vp = a.Vs + (size_t)b * 4096 * 768 + h * 128; ocol = h * 128;
    } else {
        const int b = u >> 6; h = (u >> 4) & 3; const int g = u & 15;
        qrow = b * 4096 + g * 256 + wid * 32; t_lo = 0; t_hi = 3; my_lo = 0; my_hi = 3;
        kld = 256; Qp = a.Qm + (size_t)qrow * 256 + h * 64; Kp = a.memK + (size_t)b * 256 * 256 + h * 64; Vp = a.memV + (size_t)b * 256 * 256 + h * 64; ocol = 768 + h * 64;
    }
    size_t ksrc[NC], vsrc[NC]; int kdst[NC], vdst[NC];
#pragma unroll
    for (int i = 0; i < NC; ++i) {
        if (KIND == 1) {
            ksrc[i] = (size_t)(tid >> 3) * 768 + i * 64 + (tid & 7) * 8; kdst[i] = i * KSUB + (tid >> 3) * KSTR + (tid & 7) * 16;
            const int key = (tid >> 4) + 32 * i; vsrc[i] = (size_t)key * 768 + (tid & 15) * 8; vdst[i] = key * VSTR + (tid & 15) * 16;
        } else {
            ksrc[i] = (size_t)(tid >> 3) * kld + (tid & 7) * 8; kdst[i] = (tid >> 3) * KSTR + (tid & 7) * 16;
            vsrc[i] = ksrc[i]; vdst[i] = (tid >> 3) * VSTR + (tid & 7) * 16;
        }
    }
    u32x4 kreg[NC], vreg[NC];
#define ATT_GLOAD(t) do { const size_t to_ = (size_t)(t) * 64 * kld; _Pragma("unroll") for (int i = 0; i < NC; ++i) { kreg[i] = *(const ATT_GAS u32x4*)(Kp + to_ + ksrc[i]); vreg[i] = *(const ATT_GAS u32x4*)(Vp + to_ + vsrc[i]); } } while (0)
#define ATT_LSTORE(kb_, vb_) do { _Pragma("unroll") for (int i = 0; i < NC; ++i) { *(ATT_LAS u32x4*)(lds + L_K + (kb_) * KBUF + kdst[i]) = kreg[i]; *(ATT_LAS u32x4*)(lds + L_V + (vb_) * VBUF + vdst[i]) = vreg[i]; } } while (0)
    ATT_GLOAD(t_lo);
    ATT_LAS float* bt = (ATT_LAS float*)(lds + L_BIAS);
    if (KIND == 0) { if (tid < 257) bt[tid] = a.relb[h * 257 + tid] * LOG2E; }
    bf16x8 qr[4];
#pragma unroll
    for (int s = 0; s < 4; ++s) qr[s] = *(const ATT_GAS bf16x8*)(Qp + (size_t)r32 * kld + 16 * s + 8 * hi);
    asm volatile("" : "+v"(qr[0]), "+v"(qr[1]), "+v"(qr[2]), "+v"(qr[3]));
    ATT_LAS bf16x8* qlds = (ATT_LAS bf16x8*)(lds + L_Q + wid * 4096) + lane;
    if (KIND == 1) {
#pragma unroll
        for (int s = 0; s < 4; ++s) qlds[64 * s] = qr[s];
    }
    f32x16 o[NDB];
#pragma unroll
    for (int db = 0; db < NDB; ++db)
#pragma unroll
        for (int r = 0; r < 16; ++r) o[db][r] = 0.f;
    float mrun = 0.f, lrun = 0.f; bool first = true;
    f32x16 negm;
#pragma unroll
    for (int r = 0; r < 16; ++r) negm[r] = 0.f;
    ATT_LSTORE(0, 0);
    if (t_lo < t_hi) ATT_GLOAD(t_lo + 1);
    asm volatile("s_waitcnt lgkmcnt(0)\n\ts_barrier" ::: "memory");
    const int g16 = lane >> 4, i16 = lane & 15;
    const int voff = (4 * hi + (i16 >> 2)) * VSTR + (16 * (g16 & 1) + 4 * (i16 & 3)) * 2;
    const bool grpB = wid >= 4;
    bf16x8 pf[2][2];
    int pend = -1, vb = 0;
#define ATT_PV(vslot) do { const ATT_LAS char* vt_ = lds + L_V + (vslot) * VBUF + voff; \
        _Pragma("unroll") for (int kb = 0; kb < 2; ++kb) _Pragma("unroll") for (int s = 0; s < 2; ++s) _Pragma("unroll") for (int db = 0; db < NDB; ++db) { \
            const ATT_LAS char* vp = vt_ + (32 * kb + 16 * s) * VSTR + db * 64; const s16x4 lo = vtr(vp), hi4 = vtr(vp + 8 * VSTR); \
            const bf16x8 vf = (bf16x8){lo[0], lo[1], lo[2], lo[3], hi4[0], hi4[1], hi4[2], hi4[3]}; \
            o[db] = __builtin_amdgcn_mfma_f32_32x32x16_bf16(vf, pf[kb][s], o[db], 0, 0, 0); } } while (0)
#pragma unroll 1
    for (int t = t_lo; t <= t_hi; ++t) {
        const int buf = (t - t_lo) & 1;
        if (t == t_hi && threadIdx.x == 0) nxt = (int)__hip_atomic_fetch_add(ctr, 1u, __ATOMIC_RELAXED, __HIP_MEMORY_SCOPE_AGENT);
        if (pend >= 0) { ATT_PV(pend); pend = -1; }
        if (t >= my_lo && t <= my_hi) {
            const ATT_LAS char* kt = lds + L_K + buf * KBUF + (KIND == 1 ? map * KSUB : 0);
            f32x16 p0, p1;
#pragma unroll
            for (int s = 0; s < 4; ++s) {
                const bf16x8 k0 = *(const ATT_LAS bf16x8*)(kt + r32 * KSTR + s * 32 + hi * 16);
                const bf16x8 k1 = *(const ATT_LAS bf16x8*)(kt + (r32 + 32) * KSTR + s * 32 + hi * 16);
                const bf16x8 qf = (KIND == 1) ? qlds[64 * s] : qr[s];
                if (s == 0) { p0 = __builtin_amdgcn_mfma_f32_32x32x16_bf16(k0, qf, negm, 0, 0, 0); p1 = __builtin_amdgcn_mfma_f32_32x32x16_bf16(k1, qf, negm, 0, 0, 0); }
                else { p0 = __builtin_amdgcn_mfma_f32_32x32x16_bf16(k0, qf, p0, 0, 0, 0); p1 = __builtin_amdgcn_mfma_f32_32x32x16_bf16(k1, qf, p1, 0, 0, 0); }
            }
            asm volatile("s_nop 15\n\ts_nop 7" : "+v"(p0), "+v"(p1));
            if (KIND == 0) {
                const int j = wchunk - t;
                if (j >= 3) { const float cb = bt[256];
#pragma unroll
                    for (int r = 0; r < 16; ++r) { p0[r] += cb; p1[r] += cb; }
                } else {
                    const int base = 128 + 64 * j + 32 * (wid & 1) + r32 - 4 * hi;
#pragma unroll
                    for (int r = 0; r < 16; ++r) {
                        int i0 = base - ((r & 3) + 8 * (r >> 2)); int i1 = i0 - 32;
                        i0 = i0 > 256 ? 256 : i0; i1 = i1 > 256 ? 256 : i1;
                        p0[r] += bt[i0]; p1[r] += bt[i1];
                    }
                }
            }
            float mx = max3f(p0[0], p1[0], p0[1]);
#pragma unroll
            for (int r = 1; r < 15; r += 2) { mx = max3f(mx, p1[r], p0[r + 1]); }
#pragma unroll
            for (int r = 2; r < 16; r += 2) { mx = max3f(mx, p1[r], (r + 1 < 16) ? p0[r + 1] : p1[r]); }
            mx = fmaxf(fmaxf(mx, p1[15]), p0[15]);
            { auto rr = __builtin_amdgcn_permlane32_swap(__float_as_uint(mx), __float_as_uint(mx), false, false);
              mx = fmaxf(fmaxf(__uint_as_float(rr[0]), __uint_as_float(rr[1])), mx); }
            if (first || __any(mx > 8.0f)) {
                const float dl = first ? mx : fmaxf(mx, 0.f);
                first = false;
                mrun += dl;
#pragma unroll
                for (int r = 0; r < 16; ++r) { p0[r] -= dl; p1[r] -= dl; negm[r] = -mrun; }
                const float alpha = __builtin_amdgcn_exp2f(-dl);
                lrun *= alpha;
#pragma unroll
                for (int db = 0; db < NDB; ++db)
#pragma unroll
                    for (int r = 0; r < 16; ++r) o[db][r] *= alpha;
            }
            float rs0 = 0.f, rs1 = 0.f;
#pragma unroll
            for (int r = 0; r < 16; ++r) { p0[r] = __builtin_amdgcn_exp2f(p0[r]); p1[r] = __builtin_amdgcn_exp2f(p1[r]); rs0 += p0[r]; rs1 += p1[r]; }
            lrun += rs0 + rs1;
#pragma unroll
            for (int s = 0; s < 2; ++s) {
                u32x4 w0, w1;
                w0.x = cvtpk(p0[8 * s + 0], p0[8 * s + 1]); w0.y = cvtpk(p0[8 * s + 2], p0[8 * s + 3]); w0.z = cvtpk(p0[8 * s + 4], p0[8 * s + 5]); w0.w = cvtpk(p0[8 * s + 6], p0[8 * s + 7]);
                w1.x = cvtpk(p1[8 * s + 0], p1[8 * s + 1]); w1.y = cvtpk(p1[8 * s + 2], p1[8 * s + 3]); w1.z = cvtpk(p1[8 * s + 4], p1[8 * s + 5]); w1.w = cvtpk(p1[8 * s + 6], p1[8 * s + 7]);
                pf[0][s] = __builtin_bit_cast(bf16x8, w0); pf[1][s] = __builtin_bit_cast(bf16x8, w1);
            }
            if (grpB) pend = vb; else ATT_PV(vb);
        }
        const int vn = (vb == 2) ? 0 : vb + 1;
        if (t < t_hi) ATT_LSTORE(buf ^ 1, vn);
        if (t + 1 < t_hi) ATT_GLOAD(t + 2);
        vb = vn;
        asm volatile("s_waitcnt lgkmcnt(0)\n\ts_barrier" ::: "memory");
    }
    if (pend >= 0) ATT_PV(pend);
    if (KIND == 1) __syncthreads();
#undef ATT_PV
#undef ATT_GLOAD
#undef ATT_LSTORE
    const float ltot = lrun + __shfl_xor(lrun, 32), inv = 1.0f / ltot;
    if (KIND != 1) {
        ATT_GAS bf16_t* op = a.Ocat + (size_t)(qrow + r32) * 1024 + ocol + 4 * hi;
#pragma unroll
        for (int db = 0; db < NDB; ++db)
#pragma unroll
            for (int g4 = 0; g4 < 4; ++g4) {
                u32x2 w; w.x = cvtpk(o[db][4 * g4 + 0] * inv, o[db][4 * g4 + 1] * inv); w.y = cvtpk(o[db][4 * g4 + 2] * inv, o[db][4 * g4 + 3] * inv);
                *(ATT_GAS u32x2*)(op + 32 * db + 8 * g4) = w;
            }
    } else {
        ATT_LAS float* ex = (ATT_LAS float*)lds + (wid & 3) * 4096;
        if (map == 1) {
#pragma unroll
            for (int db = 0; db < NDB; ++db)
#pragma unroll
                for (int r = 0; r < 16; ++r) ex[(db * 16 + r) * 64 + lane] = o[db][r] * inv;
        }
        __syncthreads();
        if (map == 0) {
            float sq = 0.f;
#pragma unroll
            for (int db = 0; db < NDB; ++db)
#pragma unroll
                for (int r = 0; r < 16; ++r) { const float v = o[db][r] * inv - a.lam * ex[(db * 16 + r) * 64 + lane]; o[db][r] = v; sq += v * v; }
            sq += __shfl_xor(sq, 32);
            const float rsn = rsqrtf(sq * (1.0f / 128.0f) + RMS_EPS) * a.one_m_li;
            ATT_GAS bf16_t* op = a.Ocat + (size_t)(qrow + r32) * 1024 + ocol + 4 * hi;
#pragma unroll
            for (int db = 0; db < NDB; ++db)
#pragma unroll
                for (int g4 = 0; g4 < 4; ++g4) {
                    const f32x4 gn = *(const ATT_GAS f32x4*)(a.subln + 32 * db + 8 * g4 + 4 * hi);
                    u32x2 w; w.x = cvtpk(o[db][4 * g4 + 0] * rsn * gn[0], o[db][4 * g4 + 1] * rsn * gn[1]); w.y = cvtpk(o[db][4 * g4 + 2] * rsn * gn[2], o[db][4 * g4 + 3] * rsn * gn[3]);
                    *(ATT_GAS u32x2*)(op + 32 * db + 8 * g4) = w;
                }
        }
        __syncthreads();
    }
}

__device__ __forceinline__ void attn_phase(ATT_LAS char* lds, const Args& a, int is_b, ATT_GAS unsigned* ctr) {
    volatile ATT_LAS int* misc = (volatile ATT_LAS int*)(lds + L_MISC);
    __syncthreads();
    if (threadIdx.x == 0) misc[0] = (int)__hip_atomic_fetch_add(ctr, 1u, __ATOMIC_RELAXED, __HIP_MEMORY_SCOPE_AGENT);
    __syncthreads();
    int u = __builtin_amdgcn_readfirstlane(misc[0]);
    while (u < 1024) {
        int nxt = 0;
        if (u < 768) {
#ifndef NO_K1
            if (is_b) attn_unit<1>(lds, a, u, ctr, nxt);
#endif
#ifndef NO_K0
            if (!is_b) attn_unit<0>(lds, a, u, ctr, nxt);
#endif
        }
#ifndef NO_K2
        else attn_unit<2>(lds, a, u - 768, ctr, nxt);
#endif
        __syncthreads();
        if (threadIdx.x == 0) misc[0] = nxt;
        __syncthreads();
        u = __builtin_amdgcn_readfirstlane(misc[0]);
    }
}
}


#define LAS __attribute__((address_space(3)))
#ifndef PROBE_GEMM2
#define PROBE_GEMM2 0
#endif
#ifndef PROBE_ATT2
#define PROBE_ATT2 0
#endif
#ifndef PROBE_SYNC2
#define PROBE_SYNC2 0
#endif
typedef unsigned short bf16;
typedef float f32x4 __attribute__((ext_vector_type(4)));
typedef unsigned v4u __attribute__((ext_vector_type(4)));
typedef unsigned v2u __attribute__((ext_vector_type(2)));

constexpr int DMODEL = 1024, NBATCH = 4, SEQ = 4096, DEPTH = 4, MTOK = NBATCH * SEQ, DFF = 2816, NMEM = 256, MROWS = NBATCH * NMEM;
constexpr int INW = 2560, SELFW = 768, MEMW = 256;
constexpr int NWAVES = 8;
constexpr size_t MiB = 1u << 20;
constexpr size_t WS_CTL = 0;
constexpr size_t WS_SS = 13 * MiB;
constexpr size_t WS_MRSTD = 2 * MiB;
constexpr size_t WS_COS = 3 * MiB, WS_SIN = 5 * MiB;
constexpr size_t WS_MEMB = 7 * MiB;
constexpr size_t WS_MEMKV = 9 * MiB;
constexpr size_t WS_XB = 16 * MiB;
constexpr size_t WS_W = 48 * MiB, W_LAYER = 41 * MiB;
constexpr size_t WO_GU1 = 0, WO_D1 = 11 * MiB, WO_IN = WO_D1 + 5632 * 1024, WO_MKV = WO_IN + 5 * MiB, WO_OUT = WO_MKV + 1 * MiB, WO_GU2 = WO_OUT + 2 * MiB, WO_D2 = WO_GU2 + 11 * MiB;
static_assert(WO_D2 + 5632 * 1024 == W_LAYER, "weight map");
constexpr size_t WS_ACT = WS_W + DEPTH * W_LAYER;
constexpr size_t AO_Q = 0, AO_K = 24 * MiB, AO_V = 48 * MiB, AO_QM = 72 * MiB, AO_O = 80 * MiB, ACT_BYTES = 112 * MiB;
constexpr size_t WS_XL = WS_ACT + ACT_BYTES;
constexpr size_t WS_END = WS_XL + 32 * MiB;
constexpr int LDS_BYTES = 151552;

struct KArgs { const void* in[28]; float* out; unsigned char* ws; int op_lo, op_hi; };

__device__ __forceinline__ unsigned f2bf(float f) { unsigned u = __builtin_bit_cast(unsigned, f); return (u + 0x7fffu + ((u >> 16) & 1u)) >> 16; }
__device__ __forceinline__ unsigned pk2(float lo, float hi) { return f2bf(lo) | (f2bf(hi) << 16); }
__device__ __forceinline__ float wave_sum(float v) {
#pragma unroll
    for (int o = 1; o < 64; o <<= 1) v += __shfl_xor(v, o);
    return v;
}
__device__ __forceinline__ void transpose_item(const float* W, int K, int N, bf16* WT, const float* gain, LAS float* scr, int item, int lane, int mode) {
    const int nblk = N / 32, kb = item / nblk, nb = item % nblk, k0 = 64 * kb, n0 = 32 * nb;
    int drow0;
    if (mode == 0) drow0 = n0;
    else if (mode == 1) drow0 = 256 * (n0 >> 7) + (n0 & 127);
    else if (mode == 2) drow0 = 256 * (n0 >> 7) + 128 + (n0 & 127);
    else drow0 = 256 * (n0 >> 8) + 128 * ((n0 >> 5) & 1) + 32 * ((n0 >> 6) & 3);
    const int q = lane & 7, r = lane >> 3;
    f32x4 v[8];
#pragma unroll
    for (int i = 0; i < 8; ++i) v[i] = *(const f32x4*)(W + (size_t)(k0 + 8 * i + r) * N + n0 + 4 * q);
    if (gain) {
#pragma unroll
        for (int i = 0; i < 8; ++i) v[i] = v[i] * gain[k0 + 8 * i + r];
    }
#pragma unroll
    for (int i = 0; i < 8; ++i) { LAS float* s = scr + (8 * i + r) * 33 + 4 * q; s[0] = v[i][0]; s[1] = v[i][1]; s[2] = v[i][2]; s[3] = v[i][3]; }
    asm volatile("s_waitcnt lgkmcnt(0)" ::: "memory");
    const int c = lane & 7;
#pragma unroll
    for (int j = 0; j < 4; ++j) { const int n = (lane >> 3) + 8 * j; const LAS float* s = scr + (8 * c) * 33 + n;
        v4u o; o.x = pk2(s[0 * 33], s[1 * 33]); o.y = pk2(s[2 * 33], s[3 * 33]); o.z = pk2(s[4 * 33], s[5 * 33]); o.w = pk2(s[6 * 33], s[7 * 33]);
        *(v4u*)(WT + (size_t)(drow0 + n) * K + k0 + 8 * c) = o; }
    asm volatile("s_waitcnt lgkmcnt(0)" ::: "memory");
}

__device__ __forceinline__ void prologue(const KArgs& A, LAS unsigned char* lds, int tid, int lane, int wave) {
    unsigned char* ws = A.ws;
    LAS float* scr = (LAS float*)(lds + wave * 8448);
    const int G = gridDim.x, gw = blockIdx.x * NWAVES + wave, NGW = G * NWAVES;
    constexpr int I_G = 16 * 88, I_D = 44 * 32, I_IN = 16 * 80, I_MKV = 16 * 16, I_OUT = 16 * 32, I_LAYER = 6 * I_G + I_IN + I_MKV + I_OUT;
    static_assert(I_G == I_D, "items");
    for (int it = gw; it < DEPTH * I_LAYER; it += NGW) {
        const int L = it / I_LAYER; int r = it % I_LAYER;
        bf16* wl = (bf16*)(ws + WS_W + (size_t)L * W_LAYER);
        const size_t o_gu = (size_t)L * DMODEL * DFF, o_n = (size_t)L * DMODEL;
        if (r < I_G) { transpose_item((const float*)A.in[4] + o_gu, DMODEL, DFF, (bf16*)((unsigned char*)wl + WO_GU1), (const float*)A.in[3] + o_n, scr, r, lane, 1); continue; } r -= I_G;
        if (r < I_G) { transpose_item((const float*)A.in[5] + o_gu, DMODEL, DFF, (bf16*)((unsigned char*)wl + WO_GU1), (const float*)A.in[3] + o_n, scr, r, lane, 2); continue; } r -= I_G;
        if (r < I_D) { transpose_item((const float*)A.in[6] + o_gu, DFF, DMODEL, (bf16*)((unsigned char*)wl + WO_D1), nullptr, scr, r, lane, 0); continue; } r -= I_D;
        if (r < I_IN) { transpose_item((const float*)A.in[9] + (size_t)L * DMODEL * INW, DMODEL, INW, (bf16*)((unsigned char*)wl + WO_IN), (const float*)A.in[7] + o_n, scr, r, lane, 3); continue; } r -= I_IN;
        if (r < I_MKV) { transpose_item((const float*)A.in[10] + (size_t)L * DMODEL * 512, DMODEL, 512, (bf16*)((unsigned char*)wl + WO_MKV), (const float*)A.in[8] + o_n, scr, r, lane, 3); continue; } r -= I_MKV;
        if (r < I_OUT) { transpose_item((const float*)A.in[13] + (size_t)L * DMODEL * DMODEL, DMODEL, DMODEL, (bf16*)((unsigned char*)wl + WO_OUT), nullptr, scr, r, lane, 0); continue; } r -= I_OUT;
        if (r < I_G) { transpose_item((const float*)A.in[25] + o_gu, DMODEL, DFF, (bf16*)((unsigned char*)wl + WO_GU2), (const float*)A.in[24] + o_n, scr, r, lane, 1); continue; } r -= I_G;
        if (r < I_G) { transpose_item((const float*)A.in[26] + o_gu, DMODEL, DFF, (bf16*)((unsigned char*)wl + WO_GU2), (const float*)A.in[24] + o_n, scr, r, lane, 2); continue; } r -= I_G;
        transpose_item((const float*)A.in[27] + o_gu, DFF, DMODEL, (bf16*)((unsigned char*)wl + WO_D2), nullptr, scr, r, lane, 0);
    }
    float* ss = (float*)(ws + WS_SS);
    for (int m = gw; m < MTOK + MROWS; m += NGW) {
        const bool ismem = m >= MTOK; const int row = ismem ? m - MTOK : m;
        const f32x4* xr = (const f32x4*)((ismem ? (const float*)A.in[1] : (const float*)A.in[0]) + (size_t)row * DMODEL) + lane;
        f32x4 v[4]; float s = 0.f;
#pragma unroll
        for (int j = 0; j < 4; ++j) { v[j] = xr[64 * j]; s += (v[j].x * v[j].x + v[j].y * v[j].y) + (v[j].z * v[j].z + v[j].w * v[j].w); }
        s = wave_sum(s);
        bf16* ob = (bf16*)(ws + (ismem ? WS_MEMB : WS_XB)) + (size_t)row * DMODEL;
        v2u hw[4];
#pragma unroll
        for (int j = 0; j < 4; ++j) { hw[j].x = pk2(v[j].x, v[j].y); hw[j].y = pk2(v[j].z, v[j].w); *((v2u*)ob + lane + 64 * j) = hw[j]; }
        if (!ismem) {
            unsigned char* ol = ws + WS_XL + (size_t)row * DMODEL;
#pragma unroll
            for (int j = 0; j < 4; ++j) {
                const float r0 = (v[j].x - __builtin_bit_cast(float, hw[j].x << 16)) * 1024.0f, r1 = (v[j].y - __builtin_bit_cast(float, hw[j].x & 0xffff0000u)) * 1024.0f;
                const float r2 = (v[j].z - __builtin_bit_cast(float, hw[j].y << 16)) * 1024.0f, r3 = (v[j].w - __builtin_bit_cast(float, hw[j].y & 0xffff0000u)) * 1024.0f;
                unsigned w = __builtin_amdgcn_cvt_pk_fp8_f32(r0, r1, 0u, false); w = __builtin_amdgcn_cvt_pk_fp8_f32(r2, r3, w, true);
                *((unsigned*)ol + lane + 64 * j) = w; }
            if (lane < 16) ss[(size_t)row * 16 + lane] = (lane == 0) ? s : 0.f;
        } else if (lane == 0) ((float*)(ws + WS_MRSTD))[row] = rsqrtf(s * (1.0f / 1024.0f) + 1e-6f);
    }
    const int gt = blockIdx.x * (NWAVES * 64) + tid, NGT = G * NWAVES * 64;
    const int* pos = (const int*)A.in[2];
    for (int e = gt; e < MTOK * 32; e += NGT) {
        const int row = e >> 5, i = e & 31;
        const float inv_freq = 1.0f / powf(10000.0f, (float)(2 * i) / 64.0f);
        const float ang = (float)pos[row] * inv_freq;
        float sn, cs; sincosf(ang, &sn, &cs);
        ((float*)(ws + WS_COS))[e] = cs; ((float*)(ws + WS_SIN))[e] = sn;
    }
}

#define XB_TMO      128
#define XB_XCNT(j)  (256  + 64 * (j))
#define XB_XSUB(j)  (1280 + 64 * (j))
#define XB_XGEN(j)  (2304 + 64 * (j))
#define XB_TOP      3328
#define XB_TOPGEN   3392
#define XCD_BAR_WORDS 3456
#define XB_SPIN_CAP (1u << 18)

__device__ __forceinline__ unsigned xb_ld(unsigned* p)              { return __hip_atomic_load(p, __ATOMIC_RELAXED, __HIP_MEMORY_SCOPE_AGENT); }
__device__ __forceinline__ unsigned xb_add(unsigned* p, unsigned v) { return __hip_atomic_fetch_add(p, v, __ATOMIC_RELAXED, __HIP_MEMORY_SCOPE_AGENT); }
__device__ __forceinline__ unsigned xb_xcc_id() { return (unsigned)__builtin_amdgcn_s_getreg((3 << 11) | 20) & 0xFu; }
#define XB_SPIN(cond, bar) do { unsigned _sp = 0; while (cond) { __builtin_amdgcn_s_sleep(1); \
    if ((++_sp & 255u) == 0u) { if (xb_ld(&(bar)[XB_TMO])) break; if (_sp > XB_SPIN_CAP) { atomicAdd(&(bar)[XB_TMO], 1u); break; } } } } while (0)

struct XcdBarrier {
    unsigned* bar; unsigned x;
    volatile LAS unsigned* st;
};

__device__ __forceinline__ XcdBarrier xcd_barrier_post(unsigned* bar, volatile LAS unsigned* st) {
    XcdBarrier b; b.bar = bar; b.x = xb_xcc_id(); b.st = st;
    if (threadIdx.x == 0) (void)xb_add(&bar[XB_XCNT(b.x)], 1u);
    return b;
}
__device__ __forceinline__ void xcd_barrier_complete(unsigned* bar, unsigned x, unsigned& nloc, unsigned& nx) {
    const unsigned G = gridDim.x * gridDim.y * gridDim.z;
    unsigned sum, cnt, mine, sp = 0u;
    for (;;) {
        sum = 0u; cnt = 0u; mine = 0u;
#pragma unroll
        for (unsigned j = 0; j < 16; ++j) { const unsigned c = xb_ld(&bar[XB_XCNT(j)]); sum += c; cnt += (c > 0u) ? 1u : 0u; mine = (j == x) ? c : mine; }
        if (sum == G) break;
        __builtin_amdgcn_s_sleep(1);
        if ((++sp & 255u) == 0u) { if (xb_ld(&bar[XB_TMO])) break; if (sp > XB_SPIN_CAP) { atomicAdd(&bar[XB_TMO], 1u); break; } }
    }
    nloc = mine > 0u ? mine : 1u; nx = cnt > 0u ? cnt : 1u;
}

__device__ __forceinline__ void xcd_barrier(const XcdBarrier& b) {
    asm volatile("s_waitcnt vmcnt(0)" ::: "memory");
    __syncthreads();
    if (threadIdx.x == 0) {
        unsigned* bar = b.bar;
        __builtin_amdgcn_s_waitcnt(0);
        unsigned nloc = b.st[0], nx = b.st[1];
        if (nloc == 0u) { xcd_barrier_complete(bar, b.x, nloc, nx); b.st[0] = nloc; b.st[1] = nx; }
        const unsigned old = xb_add(&bar[XB_XSUB(b.x)], 1u);
        const unsigned gen = old / nloc;
        if (old + 1u == (gen + 1u) * nloc) {
            __builtin_amdgcn_fence(__ATOMIC_RELEASE, "agent");
            asm volatile("s_waitcnt vmcnt(0)" ::: "memory");
            const unsigned og = xb_add(&bar[XB_TOP], 1u);
            const unsigned tg = og / nx;
            if (og + 1u == (tg + 1u) * nx) xb_add(&bar[XB_TOPGEN], 1u);
            else XB_SPIN(xb_ld(&bar[XB_TOPGEN]) == tg, bar);
            __builtin_amdgcn_fence(__ATOMIC_ACQUIRE, "agent");
            xb_add(&bar[XB_XGEN(b.x)], 1u);
            asm volatile("s_waitcnt vmcnt(0)" ::: "memory");
        } else {
            XB_SPIN(xb_ld(&bar[XB_XGEN(b.x)]) == gen, bar);
            __builtin_amdgcn_fence(__ATOMIC_ACQUIRE, "agent");
            asm volatile("s_waitcnt vmcnt(0)" ::: "memory");
        }
    }
    __syncthreads();
}

constexpr size_t WS_BAR = 128 * 1024;
constexpr int LDS_BARW = 151552 - 64;

constexpr int NOPS = 4 + 7 * DEPTH;
constexpr size_t WS_TAB = 64 * 1024;
__device__ __forceinline__ void write_table(const KArgs& A) {
    unsigned char* ws = A.ws;
    pg8::OpDesc* tab = (pg8::OpDesc*)(ws + WS_TAB);
    float* ss = (float*)(ws + WS_SS);
    bf16* XB = (bf16*)(ws + WS_XB);
    bf16* HMID = (bf16*)(ws + WS_ACT);
    bf16 *Qs = (bf16*)(ws + WS_ACT + AO_Q), *Ks = (bf16*)(ws + WS_ACT + AO_K), *Vs = (bf16*)(ws + WS_ACT + AO_V), *Qm = (bf16*)(ws + WS_ACT + AO_QM), *Ocat = (bf16*)(ws + WS_ACT + AO_O);
    const float* cosT = (const float*)(ws + WS_COS); const float* sinT = (const float*)(ws + WS_SIN);
#pragma unroll 1
    for (int op = 0; op < NOPS; ++op) {
        pg8::OpDesc* d = tab + op;
#pragma unroll
        for (int i = 0; i < 10; ++i) d->p[i] = nullptr;
        d->f[0] = 0.f; d->f[1] = 0.f; d->i[0] = 0; d->i[1] = 0;
        if (op < 4) {
            const int L = op; const unsigned char* wl = ws + WS_W + (size_t)L * W_LAYER;
            d->type = 2; d->M = MROWS; d->N = 512; d->K = DMODEL; d->A = (const bf16*)(ws + WS_MEMB); d->Bt = (const bf16*)(wl + WO_MKV);
            d->p[0] = ws + WS_MRSTD; d->p[2] = ws + WS_MEMKV + (size_t)L * MiB; d->p[3] = ws + WS_MEMKV + (size_t)L * MiB + MiB / 2; d->p[6] = (const float*)A.in[12] + L * 64;
            d->i[0] = 2; d->i[1] = 128 + 8 * L;
        } else {
            const int L = (op - 4) / 7, k = (op - 4) % 7, j2 = L >> 1; const bool isb = (L & 1) != 0;
            const unsigned char* wl = ws + WS_W + (size_t)L * W_LAYER;
            if (k == 0 || k == 5) {
                d->type = 0; d->M = MTOK; d->N = 2 * DFF; d->K = DMODEL; d->A = XB; d->Bt = (const bf16*)(wl + (k == 0 ? WO_GU1 : WO_GU2));
                d->p[0] = HMID; d->p[1] = ss + (size_t)((3 * L + (k == 0 ? 0 : 2)) % 3) * MTOK * 16;
            } else if (k == 1 || k == 4 || k == 6) {
                d->type = 1; d->M = MTOK; d->N = DMODEL; d->K = (k == 4) ? DMODEL : DFF; d->A = (k == 4) ? Ocat : HMID;
                d->Bt = (const bf16*)(wl + ((k == 1) ? WO_D1 : (k == 4 ? WO_OUT : WO_D2)));
                const int nss = 3 * L + (k == 1 ? 1 : (k == 4 ? 2 : 3));
                d->p[0] = ws + WS_XL; d->p[1] = XB; d->p[2] = ss + (size_t)(nss % 3) * MTOK * 16; d->p[3] = A.out; d->f[0] = (k == 4) ? 1.0f : 0.5f; d->i[0] = (op == NOPS - 1) ? 1 : 0;
            } else if (k == 2) {
                d->type = 2; d->M = MTOK; d->N = INW; d->K = DMODEL; d->A = XB; d->Bt = (const bf16*)(wl + WO_IN);
                d->p[0] = ss + (size_t)((3 * L + 1) % 3) * MTOK * 16; d->p[1] = Qs; d->p[2] = Ks; d->p[3] = Vs; d->p[4] = Qm;
                d->p[5] = (isb ? (const float*)A.in[17] : (const float*)A.in[14]) + j2 * 64; d->p[6] = (isb ? (const float*)A.in[18] : (const float*)A.in[15]) + j2 * 64; d->p[7] = (const float*)A.in[11] + L * 64;
                d->p[8] = cosT; d->p[9] = sinT; d->i[0] = 1 | (isb ? 4 : 0);
            } else {
                d->type = 3; d->M = 0; d->N = 0; d->K = 0; d->A = nullptr; d->Bt = nullptr;
                d->p[0] = Qs; d->p[1] = Ks; d->p[2] = Vs; d->p[3] = Qm; d->p[4] = Ocat; d->p[5] = ws + WS_MEMKV + (size_t)L * MiB; d->p[6] = ws + WS_MEMKV + (size_t)L * MiB + MiB / 2;
                d->p[7] = (const float*)A.in[16] + (size_t)j2 * 12 * 257; d->p[8] = (const float*)A.in[23] + j2 * 128; d->p[9] = (unsigned*)(ws + WS_CTL) + 16 * L;
                d->i[0] = isb ? 1 : 0; d->f[1] = 1.f;
                if (isb) {
                    const float li = 0.8f - 0.6f * expf(-0.3f * (float)L);
                    const float *q1 = (const float*)A.in[19] + j2 * 64, *k1 = (const float*)A.in[20] + j2 * 64, *q2 = (const float*)A.in[21] + j2 * 64, *k2 = (const float*)A.in[22] + j2 * 64;
                    float s1 = 0.f, s2 = 0.f;
#pragma unroll 1
                    for (int i = 0; i < 64; ++i) { s1 += q1[i] * k1[i]; s2 += q2[i] * k2[i]; }
                    d->f[0] = expf(s1) - expf(s2) + li; d->f[1] = 1.0f - li;
                }
            }
        }
    }
}

__global__ void __launch_bounds__(NWAVES * 64, 2) mega_fwd(KArgs A) {
    extern __shared__ __attribute__((aligned(16))) unsigned char lds_raw[];
    cg::grid_group grid = cg::this_grid();
    LAS unsigned char* lds = (LAS unsigned char*)lds_raw;
    const int tid = threadIdx.x, lane = tid & 63, wave = __builtin_amdgcn_readfirstlane(tid >> 6);
    if (tid < 2) ((volatile LAS unsigned*)(lds + LDS_BARW))[tid] = 0u;
    __syncthreads();
    XcdBarrier xbar = xcd_barrier_post((unsigned*)(A.ws + WS_BAR), (volatile LAS unsigned*)(lds + LDS_BARW));
    if (A.op_lo < 0) {
#ifndef NO_TAB
        if (blockIdx.x == 0 && tid == 0) write_table(A);
#endif
#ifndef NO_PRO
        prologue(A, lds, tid, lane, wave);
#endif
        if (A.op_hi > 0) xcd_barrier(xbar);
        if (A.op_hi < -5) grid.sync();
    }
    const pg8::OpDesc* tab = (const pg8::OpDesc*)(A.ws + WS_TAB);
    const int op_lo = A.op_lo < 0 ? 0 : A.op_lo, op_hi = A.op_hi;
#pragma unroll 1
    for (int op = op_lo; op < op_hi; ++op) {
        const pg8::OpDesc* d = tab + op;
        const int type = __builtin_amdgcn_readfirstlane(d->type);
        if (type == 3) {
            att::Args a;
            a.Qs = (const ATT_GAS bf16*)d->p[0]; a.Ks = (const ATT_GAS bf16*)d->p[1]; a.Vs = (const ATT_GAS bf16*)d->p[2]; a.Qm = (const ATT_GAS bf16*)d->p[3]; a.Ocat = (ATT_GAS bf16*)d->p[4];
            a.memK = (const ATT_GAS bf16*)d->p[5]; a.memV = (const ATT_GAS bf16*)d->p[6]; a.relb = (const ATT_GAS float*)d->p[7]; a.subln = (const ATT_GAS float*)d->p[8];
            a.lam = d->f[0]; a.one_m_li = d->f[1];
#ifndef NO_ATT
            att::attn_phase((__attribute__((address_space(3))) char*)lds, a, d->i[0], (ATT_GAS unsigned*)d->p[9]);
#if PROBE_ATT2
            xcd_barrier(xbar);
            att::attn_phase((__attribute__((address_space(3))) char*)lds, a, d->i[0], (ATT_GAS unsigned*)d->p[9] + 8);
#endif
#endif
        } else {
            const int G = gridDim.x, bx = blockIdx.x;
            pg8::Gemm g{(const pg8::bf16_t*)(const ATT_GAS pg8::bf16_t*)d->A, (const pg8::bf16_t*)(const ATT_GAS pg8::bf16_t*)d->Bt, d->M, d->N, d->K};
            pg8::StaticOrder S; S.init(d->M, d->N, G, (((bx - d->i[1]) % G) + G) % G);
#if PROBE_GEMM2
            for (int rep = ((PROBE_GEMM2 >> type) & 1) ? 0 : 1; rep < 2; ++rep) {
            if (rep == 1 && ((PROBE_GEMM2 >> type) & 1)) xcd_barrier(xbar);
#endif
#ifndef NO_GU
            if (type == 0) { pg8::EpiGateUp E{d}; pg8::gemm_phase<pg8::EpiGateUp, pg8::StaticOrder, true, true>(lds, g, S, E); }
#endif
#ifndef NO_RES
#if PROBE_GEMM2
            const float smul = (rep == 0) ? 0.f : 1.f;
#else
            const float smul = 1.f;
#endif
            if (type == 1) { pg8::EpiResid E{d, smul}; pg8::gemm_phase<pg8::EpiResid, pg8::StaticOrder, true, true>(lds, g, S, E); }
#endif
#ifndef NO_PROJ
            if (type == 2) { pg8::EpiProj E{d}; pg8::gemm_phase<pg8::EpiProj, pg8::StaticOrder, true, true>(lds, g, S, E); }
#endif
#if PROBE_GEMM2
            }
#endif
        }
        if (op >= 4 && op + 1 < op_hi) xcd_barrier(xbar);
#if PROBE_SYNC2
        if (op >= 4 && op + 1 < op_hi) { xcd_barrier(xbar); xcd_barrier(xbar); xcd_barrier(xbar); xcd_barrier(xbar); }
#endif
    }
}

extern "C" void kernel_launch(void* const* d_in, const int* in_sizes, int n_in, void* d_out, int out_size, void* d_ws, size_t ws_size, hipStream_t stream) {
    static int grid = 0;
    if (grid == 0) {
        if (n_in != 28 || out_size != MTOK * DMODEL || ws_size < WS_END) { fprintf(stderr, "kernel_launch: unexpected problem (n_in %d, out %d, ws %zu < %zu)\n", n_in, out_size, ws_size, (size_t)WS_END); grid = -1; return; }
        int dev = 0, cus = 0, per_cu = 0;
        hipGetDevice(&dev); hipDeviceGetAttribute(&cus, hipDeviceAttributeMultiprocessorCount, dev);
        if (hipFuncSetAttribute((const void*)mega_fwd, hipFuncAttributeMaxDynamicSharedMemorySize, LDS_BYTES) != hipSuccess) { fprintf(stderr, "kernel_launch: hipFuncSetAttribute failed\n"); grid = -1; return; }
        if (hipOccupancyMaxActiveBlocksPerMultiprocessor(&per_cu, (const void*)mega_fwd, NWAVES * 64, LDS_BYTES) != hipSuccess || per_cu < 1) { fprintf(stderr, "kernel_launch: occupancy query gives %d\n", per_cu); per_cu = 1; }
        (void)hipGetLastError();
        grid = cus * per_cu;
        fprintf(stderr, "kernel_launch: grid %d (cus %d x %d)\n", grid, cus, per_cu);
    }
    if (grid < 0) return;
    if (hipMemsetAsync((char*)d_ws + WS_CTL, 0, 256 * 1024, stream) != hipSuccess) { fprintf(stderr, "kernel_launch: memset failed\n"); return; }
    KArgs a{};
    for (int i = 0; i < 28; ++i) a.in[i] = d_in[i];
    a.out = (float*)d_out; a.ws = (unsigned char*)d_ws; a.op_lo = -1; a.op_hi = NOPS;
    void* params[] = {&a};
    hipError_t e = hipLaunchCooperativeKernel((const void*)mega_fwd, dim3(grid), dim3(NWAVES * 64), params, LDS_BYTES, stream);
    if (e != hipSuccess) fprintf(stderr, "kernel_launch: cooperative launch failed: %s (grid %d)\n", hipGetErrorString(e), grid);
}
```

```cpp
#include <hip/hip_runtime.h>
#include <hip/hip_cooperative_groups.h>
#include <cstdio>
#include <cstdint>
namespace cg = cooperative_groups;

namespace pg8 {
#define PG8_LAS __attribute__((address_space(3)))
typedef unsigned short bf16_t;
typedef short bf16x8 __attribute__((ext_vector_type(8)));
typedef float f32x4 __attribute__((ext_vector_type(4)));
typedef unsigned u32x4 __attribute__((ext_vector_type(4)));
constexpr int BM = 256, BK = 64, HALF = 128, HTB = HALF * BK * 2  , STAGE_BYTES = 8 * HTB, NXCD = 8, WGM = 8;

__host__ __device__ __forceinline__ int lds_byte(int r, int c) { const int st = (r >> 4) * 2 + (c >> 5), rr = r & 15, cc = c & 31, ob = rr * 64 + cc * 2; return st * 1024 + (ob ^ (((ob >> 9) & 1) << 5)); }
__host__ __device__ __forceinline__ void stage_rc(int b, int& R, int& C) { const int st = b / 1024, sb = b % 1024, swz = sb ^ (((sb >> 9) & 1) << 5); R = (st >> 1) * 16 + swz / 64; C = (st & 1) * 32 + (swz % 64) / 2; }
__host__ __device__ __forceinline__ int perm32(int rho) { const int n = rho >> 4, i = rho & 15; return 8 * (i >> 2) + 4 * n + (i & 3); }

struct Unit { int pm, pn; };
struct Gemm { const bf16_t* A; const bf16_t* Bt; int M, N, K; };

struct StaticOrder {
    int nM, nN, nwg, G, c;
    __host__ __device__ void init(int M, int N, int G_, int c_) { nM = M / BM; nN = N / BM; nwg = nM * nN; G = G_; c = c_; }
    __host__ __device__ bool next(int i, Unit& u) const {
        const long L = (long)i * G + c; if (L >= nwg) return false;
        int wgid = (int)L; { const int q = nwg / NXCD, r = nwg % NXCD, xcd = wgid % NXCD, off = wgid / NXCD; wgid = (xcd < r ? xcd * (q + 1) : r * (q + 1) + (xcd - r) * q) + off; }
        const int nig = WGM * nN, gid = wgid / nig, fm = gid * WGM, gsz = (nM - fm) < WGM ? (nM - fm) : WGM;
        u.pm = fm + ((wgid % nig) % gsz); u.pn = (wgid % nig) / gsz; return true;
    }
    __device__ __forceinline__ void a_ready(const Unit&) const {}
    __device__ __forceinline__ void done(const Unit&) const {}
};


__device__ __forceinline__ unsigned cvt_pk_bf16(float lo, float hi) { unsigned r; asm volatile("v_cvt_pk_bf16_f32 %0, %1, %2" : "=v"(r) : "v"(lo), "v"(hi)); return r; }
typedef float f32x2 __attribute__((ext_vector_type(2)));


#define PG8_GAS __attribute__((address_space(1)))
constexpr float RMS_EPS = 1e-6f;
constexpr float QK_C2 = 0.125f * 1.4426950408889634f;
__device__ __forceinline__ float fast_silu(float g) { return g * __builtin_amdgcn_rcpf(1.0f + __builtin_amdgcn_exp2f(-1.4426950408889634f * g)); }


struct OpDesc {
    int type, M, N, K;
    const bf16_t* A; const bf16_t* Bt;
    const void* p[10];
    float f[2]; int i[2];
};
static_assert(sizeof(OpDesc) == 128, "OpDesc");

__device__ __forceinline__ void row_rstd8(const PG8_GAS float* ssp, int row0, int fq, float (&rstd)[8]) {
    f32x4 t[8];
#pragma unroll
    for (int i = 0; i < 8; ++i) t[i] = *(const PG8_GAS f32x4*)(ssp + (size_t)(row0 + (i >> 2) * HALF + (i & 3) * 16) * 16 + 4 * fq);
#pragma unroll
    for (int i = 0; i < 8; ++i) { float s = (t[i][0] + t[i][1]) + (t[i][2] + t[i][3]); s += __shfl_xor(s, 16); s += __shfl_xor(s, 32); rstd[i] = rsqrtf(s * (1.0f / 1024.0f) + RMS_EPS); }
}

__device__ __forceinline__ void row_ms8(const PG8_GAS float* ssp, int row0, int fq, float (&ms)[8]) {
    f32x4 t[8];
#pragma unroll
    for (int i = 0; i < 8; ++i) t[i] = *(const PG8_GAS f32x4*)(ssp + (size_t)(row0 + (i >> 2) * HALF + (i & 3) * 16) * 16 + 4 * fq);
#pragma unroll
    for (int i = 0; i < 8; ++i) { float s = (t[i][0] + t[i][1]) + (t[i][2] + t[i][3]); s += __shfl_xor(s, 16); s += __shfl_xor(s, 32); ms[i] = s * (1.0f / 1024.0f) + RMS_EPS; }
}

struct EpiCtx { int ui; PG8_LAS unsigned char* lds; int tid; };
constexpr int STAT_OFF = STAGE_BYTES + 1024;

struct EpiGateUp {
    static constexpr bool PERM = true, AFTER_DRAIN = false;
    const OpDesc* d;
    __device__ __forceinline__ void operator()(const f32x4 (&acc)[2][2][4][2], const Unit& u, int wr, int wc, int fr, int fq, const EpiCtx& c) const {
        PG8_GAS bf16_t* H = (PG8_GAS bf16_t*)d->p[0]; const PG8_GAS float* ss = (const PG8_GAS float*)d->p[1]; const int ldh = 2816;
        const int row0 = u.pm * BM + wr * 64 + fr, col0 = u.pn * HALF + wc * 32 + 8 * fq;
        float ms8[8];
        PG8_LAS float* slot = (PG8_LAS float*)(c.lds + STAT_OFF) + c.tid;
        PG8_LAS int* pmslot = (PG8_LAS int*)(slot + 8 * 512);
        if (c.ui == 0 || pmslot[0] != u.pm) { row_ms8(ss, row0, fq, ms8); pmslot[0] = u.pm;
#pragma unroll
            for (int i = 0; i < 8; ++i) slot[i * 512] = ms8[i]; }
        else {
#pragma unroll
            for (int i = 0; i < 8; ++i) ms8[i] = slot[i * 512];
        }
#pragma unroll
        for (int ai = 0; ai < 2; ++ai)
#pragma unroll
            for (int m = 0; m < 4; ++m) {
                const int row = row0 + ai * HALF + m * 16;
                const float ms = ms8[ai * 4 + m], c = -1.4426950408889634f * rsqrtf(ms);
                float hv[8];
#pragma unroll
                for (int n = 0; n < 2; ++n)
#pragma unroll
                    for (int jp = 0; jp < 2; ++jp) {
                        const f32x2 g = (f32x2){acc[ai][0][m][n][2 * jp], acc[ai][0][m][n][2 * jp + 1]}, uu = (f32x2){acc[ai][1][m][n][2 * jp], acc[ai][1][m][n][2 * jp + 1]};
                        const f32x2 t = g * c; f32x2 ee; ee.x = __builtin_amdgcn_exp2f(t.x); ee.y = __builtin_amdgcn_exp2f(t.y);
                        const f32x2 dd = ee * ms + ms; f32x2 sg; sg.x = __builtin_amdgcn_rcpf(dd.x); sg.y = __builtin_amdgcn_rcpf(dd.y);
                        const f32x2 h = (g * uu) * sg;
                        hv[4 * n + 2 * jp] = h.x; hv[4 * n + 2 * jp + 1] = h.y; }
                u32x4 w; w.x = cvt_pk_bf16(hv[0], hv[1]); w.y = cvt_pk_bf16(hv[2], hv[3]); w.z = cvt_pk_bf16(hv[4], hv[5]); w.w = cvt_pk_bf16(hv[6], hv[7]);
                *(PG8_GAS u32x4*)(H + (size_t)row * ldh + col0) = w;
            }
    }
};

__device__ __forceinline__ float bf_lo(unsigned w) { return __builtin_bit_cast(float, w << 16); }
__device__ __forceinline__ float bf_hi(unsigned w) { return __builtin_bit_cast(float, w & 0xffff0000u); }
typedef unsigned u32x2 __attribute__((ext_vector_type(2)));
struct EpiResid {
    static constexpr bool PERM = true, AFTER_DRAIN = false;
    const OpDesc* d; float smul;
    __device__ __forceinline__ void operator()(const f32x4 (&acc)[2][2][4][2], const Unit& u, int wr, int wc, int fr, int fq, const EpiCtx&) const {
        PG8_GAS unsigned char* XL = (PG8_GAS unsigned char*)d->p[0]; PG8_GAS bf16_t* XB = (PG8_GAS bf16_t*)d->p[1]; PG8_GAS float* ssn = (PG8_GAS float*)d->p[2]; PG8_GAS float* OUT = (PG8_GAS float*)d->p[3];
        const float scale = d->f[0] * smul; const bool last = d->i[0] != 0;
        const int row0 = u.pm * BM + wr * 64 + fr, col0 = u.pn * BM + wc * 32 + 8 * fq;
        u32x4 hv[3][2]; u32x2 lv[3][2];
#define RES_LOAD(set, k_) do { const size_t o_ = (size_t)(row0 + ((k_) >> 2) * HALF + ((k_) & 3) * 16) * 1024 + col0; \
            _Pragma("unroll") for (int bj = 0; bj < 2; ++bj) { hv[set][bj] = *(const PG8_GAS u32x4*)(XB + o_ + bj * HALF); lv[set][bj] = *(const PG8_GAS u32x2*)(XL + o_ + bj * HALF); } } while (0)
        RES_LOAD(0, 0); RES_LOAD(1, 1);
#pragma unroll
        for (int k = 0; k < 8; ++k) {
            const int ai = k >> 2, m = k & 3, cur = k % 3;
            if (k + 2 < 8) RES_LOAD((k + 2) % 3, k + 2);
            const int row = row0 + ai * HALF + m * 16;
            const size_t o_ = (size_t)row * 1024 + col0;
            float sq = 0.f;
#pragma unroll
            for (int bj = 0; bj < 2; ++bj) {
                float x[8];
                const f32x2 l01 = __builtin_amdgcn_cvt_pk_f32_fp8(lv[cur][bj][0], false), l23 = __builtin_amdgcn_cvt_pk_f32_fp8(lv[cur][bj][0], true);
                const f32x2 l45 = __builtin_amdgcn_cvt_pk_f32_fp8(lv[cur][bj][1], false), l67 = __builtin_amdgcn_cvt_pk_f32_fp8(lv[cur][bj][1], true);
                const float lo8[8] = {l01[0], l01[1], l23[0], l23[1], l45[0], l45[1], l67[0], l67[1]};
#pragma unroll
                for (int q = 0; q < 4; ++q) {
                    x[2 * q] = (bf_lo(hv[cur][bj][q]) + lo8[2 * q] * (1.0f / 1024.0f)) + acc[ai][bj][m][q >> 1][(2 * q) & 3] * scale;
                    x[2 * q + 1] = (bf_hi(hv[cur][bj][q]) + lo8[2 * q + 1] * (1.0f / 1024.0f)) + acc[ai][bj][m][q >> 1][(2 * q + 1) & 3] * scale;
                }
#pragma unroll
                for (int q = 0; q < 8; ++q) sq += x[q] * x[q];
                if (last) {
                    *(PG8_GAS f32x4*)(OUT + o_ + bj * HALF) = (f32x4){x[0], x[1], x[2], x[3]}; *(PG8_GAS f32x4*)(OUT + o_ + bj * HALF + 4) = (f32x4){x[4], x[5], x[6], x[7]};
                } else {
                    u32x4 h; u32x2 l; float rr[8];
#pragma unroll
                    for (int q = 0; q < 4; ++q) { const unsigned hw = cvt_pk_bf16(x[2 * q], x[2 * q + 1]); h[q] = hw; rr[2 * q] = __builtin_amdgcn_fmed3f((x[2 * q] - bf_lo(hw)) * 1024.0f, -448.0f, 448.0f); rr[2 * q + 1] = __builtin_amdgcn_fmed3f((x[2 * q + 1] - bf_hi(hw)) * 1024.0f, -448.0f, 448.0f); }
                    l[0] = __builtin_amdgcn_cvt_pk_fp8_f32(rr[0], rr[1], 0u, false); l[0] = __builtin_amdgcn_cvt_pk_fp8_f32(rr[2], rr[3], l[0], true);
                    l[1] = __builtin_amdgcn_cvt_pk_fp8_f32(rr[4], rr[5], 0u, false); l[1] = __builtin_amdgcn_cvt_pk_fp8_f32(rr[6], rr[7], l[1], true);
                    *(PG8_GAS u32x4*)(XB + o_ + bj * HALF) = h; *(PG8_GAS u32x2*)(XL + o_ + bj * HALF) = l;
                }
            }
            sq += __shfl_xor(sq, 16); sq += __shfl_xor(sq, 32);
            if (fq == 0) ssn[(size_t)row * 16 + u.pn * 4 + wc] = sq;
        }
#undef RES_LOAD
    }
};

struct EpiProj {
    static constexpr bool PERM = true, AFTER_DRAIN = false;
    const OpDesc* d;
    __device__ __forceinline__ void operator()(const f32x4 (&acc)[2][2][4][2], const Unit& u, int wr, int wc, int fr, int fq, const EpiCtx& c) const {
        const int fl = d->i[0]; const int stat_is_ss = fl & 1, memmode = (fl >> 1) & 1, rope = (fl >> 2) & 1;
        int kind, tcol, ld;
        if (memmode) { kind = (u.pn == 0) ? 1 : 2; tcol = 0; ld = 256; }
        else { kind = u.pn < 3 ? 0 : (u.pn < 6 ? 1 : (u.pn < 9 ? 2 : 3)); tcol = (u.pn - 3 * kind) * 256; ld = (kind == 3) ? 256 : 768; }
        PG8_GAS bf16_t* out = (PG8_GAS bf16_t*)d->p[1 + kind];
        const PG8_GAS float* gp = (kind == 2) ? nullptr : (const PG8_GAS float*)d->p[kind == 3 ? 7 : 5 + kind];
        const PG8_GAS float* rowstat = (const PG8_GAS float*)d->p[0]; const PG8_GAS float* cosT = (const PG8_GAS float*)d->p[8]; const PG8_GAS float* sinT = (const PG8_GAS float*)d->p[9];
        const float sc = (kind == 0 || kind == 3) ? QK_C2 : 1.0f;
        const bool dorope = rope && kind < 2 && !memmode;
        f32x4 gv[2][2];
#pragma unroll
        for (int bj = 0; bj < 2; ++bj)
#pragma unroll
            for (int n = 0; n < 2; ++n) gv[bj][n] = gp ? *(const PG8_GAS f32x4*)(gp + 32 * bj + 8 * fq + 4 * n) : (f32x4){1.f, 1.f, 1.f, 1.f};
        const int row0 = u.pm * BM + wr * 64 + fr;
        float rstd8[8];
        PG8_LAS float* slot = (PG8_LAS float*)(c.lds + STAT_OFF) + c.tid;
        PG8_LAS int* pmslot = (PG8_LAS int*)(slot + 8 * 512);
        if (stat_is_ss && c.ui != 0 && pmslot[0] == u.pm) {
#pragma unroll
            for (int i = 0; i < 8; ++i) rstd8[i] = slot[i * 512];
        } else if (stat_is_ss) { row_rstd8(rowstat, row0, fq, rstd8); pmslot[0] = u.pm;
#pragma unroll
            for (int i = 0; i < 8; ++i) slot[i * 512] = rstd8[i]; }
        else {
#pragma unroll
            for (int i = 0; i < 8; ++i) rstd8[i] = rowstat[row0 + (i >> 2) * HALF + (i & 3) * 16];
        }
#pragma unroll
        for (int am = 0; am < 4; ++am) {
            const int ai = am >> 1;
            f32x4 cv[2][2], sv[2][2];
            if (dorope) {
#pragma unroll
                for (int m2 = 0; m2 < 2; ++m2)
#pragma unroll
                    for (int n = 0; n < 2; ++n) { const size_t o_ = (size_t)(row0 + ai * HALF + ((am & 1) * 2 + m2) * 16) * 32 + 8 * fq + 4 * n; cv[m2][n] = *(const PG8_GAS f32x4*)(cosT + o_); sv[m2][n] = *(const PG8_GAS f32x4*)(sinT + o_); }
            }
#pragma unroll
            for (int m2 = 0; m2 < 2; ++m2) {
                const int m = (am & 1) * 2 + m2;
                const int row = row0 + ai * HALF + m * 16;
                const float rs = rstd8[ai * 4 + m];
                f32x4 v[2][2];
#pragma unroll
                for (int bj = 0; bj < 2; ++bj)
#pragma unroll
                    for (int n = 0; n < 2; ++n) v[bj][n] = acc[ai][bj][m][n] * rs;
                if (gp) {
                    float sq = 0.f;
#pragma unroll
                    for (int bj = 0; bj < 2; ++bj)
#pragma unroll
                        for (int n = 0; n < 2; ++n) sq += (v[bj][n][0] * v[bj][n][0] + v[bj][n][1] * v[bj][n][1]) + (v[bj][n][2] * v[bj][n][2] + v[bj][n][3] * v[bj][n][3]);
                    sq += __shfl_xor(sq, 16); sq += __shfl_xor(sq, 32);
                    const float hr = rsqrtf(sq * (1.0f / 64.0f) + RMS_EPS);
#pragma unroll
                    for (int bj = 0; bj < 2; ++bj)
#pragma unroll
                        for (int n = 0; n < 2; ++n) v[bj][n] = v[bj][n] * hr * gv[bj][n];
                    if (dorope) {
#pragma unroll
                        for (int n = 0; n < 2; ++n) {
                            const f32x4 c = cv[m2][n], s = sv[m2][n];
                            const f32x4 x1 = v[0][n], x2 = v[1][n];
                            v[0][n] = x1 * c - x2 * s; v[1][n] = x2 * c + x1 * s;
                        }
                    }
#pragma unroll
                    for (int bj = 0; bj < 2; ++bj)
#pragma unroll
                        for (int n = 0; n < 2; ++n) v[bj][n] = v[bj][n] * sc;
                }
                PG8_GAS bf16_t* op = out + (size_t)row * ld + tcol + 64 * wc + 8 * fq;
#pragma unroll
                for (int bj = 0; bj < 2; ++bj) {
                    u32x4 w; w.x = cvt_pk_bf16(v[bj][0][0], v[bj][0][1]); w.y = cvt_pk_bf16(v[bj][0][2], v[bj][0][3]); w.z = cvt_pk_bf16(v[bj][1][0], v[bj][1][1]); w.w = cvt_pk_bf16(v[bj][1][2], v[bj][1][3]);
                    *(PG8_GAS u32x4*)(op + 32 * bj) = w;
                }
            }
        }
    }
};

template <class Epi, class Sched, bool ALIGN_EPI = false, bool SP2 = false>
__device__ __forceinline__ void gemm_phase(PG8_LAS unsigned char* lds, const Gemm g, const Sched& S, const Epi& E) {
    int tid_ = threadIdx.x; asm volatile("" : "+v"(tid_));
    const int tid = tid_, wid = __builtin_amdgcn_readfirstlane(tid >> 6), lane = tid & 63, wr = wid >> 2, wc = wid & 3, fr = lane & 15, fq = lane >> 4;
    const int K = g.K, nt = K / BK;
    unsigned voffA[2], voffB[2];
#pragma unroll
    for (int i = 0; i < 2; ++i) { int R, C; stage_rc(tid * 16 + i * 8192, R, C); const int Rb = Epi::PERM ? ((R & ~31) + perm32(R & 31)) : R;
        voffA[i] = (unsigned)(R * K + C) * 2u; voffB[i] = (unsigned)(Rb * K + C) * 2u; }
    const size_t kstep = (size_t)(BK * 2);
    const size_t hstep = (size_t)HALF * K * 2;
    const size_t tstep = 2 * hstep;
    const unsigned ldsw = (unsigned)wid * 1024u;
    const int aoff = lds_byte(wr * 64 + fr, fq * 8), boff = lds_byte(wc * 32 + fr, fq * 8);
#define PG8_SA(b, h) (((b) * 2 + (h)) * HTB)
#define PG8_SB(b, h) ((4 + (b) * 2 + (h)) * HTB)
#define PG8_STAGE(bufoff, gbase, voff) do { _Pragma("unroll") for (int _i = 0; _i < 2; ++_i) \
        __builtin_amdgcn_global_load_lds((const unsigned*)((const char*)(gbase) + (voff)[_i]), (PG8_LAS unsigned*)(lds + (bufoff) + ldsw + _i * 8192), 16, 0, 0); } while (0)
#define PG8_LDA(dst, b, h) do { _Pragma("unroll") for (int m = 0; m < 4; ++m) _Pragma("unroll") for (int k = 0; k < 2; ++k) dst[m][k] = *(const PG8_LAS bf16x8*)(lds + PG8_SA(b, h) + aoff + m * 2048 + k * 1024); } while (0)
#define PG8_LDB(dst, b, h) do { _Pragma("unroll") for (int n = 0; n < 2; ++n) _Pragma("unroll") for (int k = 0; k < 2; ++k) dst[n][k] = *(const PG8_LAS bf16x8*)(lds + PG8_SB(b, h) + boff + n * 2048 + k * 1024); } while (0)
#define PG8_MMA(ai, bj, At, Bt) do { __builtin_amdgcn_s_setprio(1); _Pragma("unroll") for (int m = 0; m < 4; ++m) _Pragma("unroll") for (int n = 0; n < 2; ++n) _Pragma("unroll") for (int k = 0; k < 2; ++k) \
        acc[ai][bj][m][n] = __builtin_amdgcn_mfma_f32_16x16x32_bf16(Bt[n][k], At[m][k], acc[ai][bj][m][n], 0, 0, 0); __builtin_amdgcn_s_setprio(0); } while (0)
#define PG8_WAIT_V(n) asm volatile("s_waitcnt vmcnt(" #n ")" ::: "memory")
#define PG8_WAIT_L(n) asm volatile("s_waitcnt lgkmcnt(" #n ")" ::: "memory")
#define PG8_BAR __builtin_amdgcn_s_barrier()
#define PG8_SCHED __builtin_amdgcn_sched_barrier(0)
    Unit cur, nxt; int ui = 0;
    if (!S.next(0, cur)) return;
    f32x4 acc[2][2][4][2];
#pragma unroll
    for (int a = 0; a < 2; ++a)
#pragma unroll
        for (int b = 0; b < 2; ++b)
#pragma unroll
            for (int m = 0; m < 4; ++m)
#pragma unroll
                for (int n = 0; n < 2; ++n) acc[a][b][m][n] = (f32x4){0.f, 0.f, 0.f, 0.f};
    bf16x8 At[4][2], B0[2][2], B1[2][2];
    const char* cA = (const char*)g.A + (size_t)cur.pm * tstep; const char* cB = (const char*)g.Bt + (size_t)cur.pn * tstep;
    S.a_ready(cur);
    if constexpr (SP2) {
        PG8_STAGE(PG8_SB(0, 0), cB, voffB); PG8_STAGE(PG8_SB(0, 1), cB + hstep, voffB); PG8_STAGE(PG8_SA(0, 0), cA, voffA); PG8_STAGE(PG8_SA(0, 1), cA + hstep, voffA);
        if (wr == 1) PG8_BAR;
        PG8_WAIT_V(2); PG8_BAR;
        PG8_STAGE(PG8_SB(1, 0), cB + kstep, voffB); PG8_STAGE(PG8_SA(1, 0), cA + kstep, voffA); PG8_STAGE(PG8_SB(1, 1), cB + hstep + kstep, voffB);
        PG8_WAIT_V(6); PG8_BAR;
    } else {
        PG8_STAGE(PG8_SB(0, 0), cB, voffB); PG8_STAGE(PG8_SA(0, 0), cA, voffA); PG8_STAGE(PG8_SB(0, 1), cB + hstep, voffB); PG8_STAGE(PG8_SA(0, 1), cA + hstep, voffA);
        if (wr == 1) PG8_BAR;
        PG8_WAIT_V(4); PG8_BAR;
        PG8_STAGE(PG8_SB(1, 0), cB + kstep, voffB); PG8_STAGE(PG8_SA(1, 0), cA + kstep, voffA); PG8_STAGE(PG8_SB(1, 1), cB + hstep + kstep, voffB);
        PG8_WAIT_V(6); PG8_BAR;
    }
    for (;;) {
        const bool has_next = S.next(ui + 1, nxt);
        const char* nA = has_next ? (const char*)g.A + (size_t)nxt.pm * tstep : cA; const char* nB = has_next ? (const char*)g.Bt + (size_t)nxt.pn * tstep : cB;
        for (int t = 0; t < nt; t += 2) {
            const bool last = (t == nt - 2);
            const char* a1 = cA + (size_t)(t + 1) * kstep;
            const char* a2 = last ? nA : cA + (size_t)(t + 2) * kstep; const char* b2 = last ? nB : cB + (size_t)(t + 2) * kstep;
            const char* a3 = a2 + kstep; const char* b3 = b2 + kstep;
            if (last && has_next) S.a_ready(nxt);
            if constexpr (SP2) {
            PG8_LDB(B0, 0, 0); PG8_LDB(B1, 0, 1); PG8_SCHED; PG8_LDA(At, 0, 0); PG8_STAGE(PG8_SA(1, 1), a1 + hstep, voffA);
            PG8_WAIT_V(8); PG8_WAIT_L(0); PG8_BAR; PG8_MMA(0, 0, At, B0); PG8_MMA(0, 1, At, B1); PG8_BAR; PG8_SCHED;
            PG8_LDA(At, 0, 1); PG8_STAGE(PG8_SB(0, 0), b2, voffB); PG8_STAGE(PG8_SB(0, 1), b2 + hstep, voffB); PG8_STAGE(PG8_SA(0, 0), a2, voffA);
            PG8_WAIT_V(8); PG8_WAIT_L(0); PG8_BAR; PG8_MMA(1, 0, At, B0); PG8_MMA(1, 1, At, B1); PG8_BAR; PG8_SCHED;
            PG8_LDB(B0, 1, 0); PG8_LDB(B1, 1, 1); PG8_SCHED; PG8_LDA(At, 1, 0); PG8_STAGE(PG8_SA(0, 1), a2 + hstep, voffA);
            PG8_WAIT_V(8); PG8_WAIT_L(0); PG8_BAR; PG8_MMA(0, 0, At, B0); PG8_MMA(0, 1, At, B1); PG8_BAR; PG8_SCHED;
            PG8_LDA(At, 1, 1); PG8_STAGE(PG8_SB(1, 0), b3, voffB); PG8_STAGE(PG8_SB(1, 1), b3 + hstep, voffB); PG8_STAGE(PG8_SA(1, 0), a3, voffA);
            PG8_WAIT_V(8); PG8_WAIT_L(0); PG8_BAR; PG8_MMA(1, 0, At, B0); PG8_MMA(1, 1, At, B1); PG8_BAR; PG8_SCHED;
            } else {
            PG8_LDB(B0, 0, 0); PG8_SCHED; PG8_LDA(At, 0, 0); PG8_STAGE(PG8_SA(1, 1), a1 + hstep, voffA);
            PG8_WAIT_L(8); PG8_BAR; PG8_WAIT_L(0); PG8_MMA(0, 0, At, B0); PG8_BAR; PG8_SCHED;
            PG8_LDB(B1, 0, 1); PG8_STAGE(PG8_SB(0, 0), b2, voffB);
            PG8_BAR; PG8_WAIT_L(0); PG8_MMA(0, 1, At, B1); PG8_BAR;
            PG8_LDA(At, 0, 1); PG8_STAGE(PG8_SA(0, 0), a2, voffA);
            PG8_BAR; PG8_WAIT_L(0); PG8_MMA(1, 0, At, B0); PG8_BAR; PG8_SCHED;
            PG8_STAGE(PG8_SB(0, 1), b2 + hstep, voffB);
            PG8_WAIT_V(6); PG8_BAR; PG8_MMA(1, 1, At, B1); PG8_BAR;
            PG8_LDB(B0, 1, 0); PG8_SCHED; PG8_LDA(At, 1, 0); PG8_STAGE(PG8_SA(0, 1), a2 + hstep, voffA);
            PG8_WAIT_L(8); PG8_BAR; PG8_WAIT_L(0); PG8_MMA(0, 0, At, B0); PG8_BAR; PG8_SCHED;
            PG8_LDB(B1, 1, 1); PG8_STAGE(PG8_SB(1, 0), b3, voffB);
            PG8_BAR; PG8_WAIT_L(0); PG8_MMA(0, 1, At, B1); PG8_BAR;
            PG8_LDA(At, 1, 1); PG8_STAGE(PG8_SA(1, 0), a3, voffA);
            PG8_BAR; PG8_WAIT_L(0); PG8_MMA(1, 0, At, B0); PG8_BAR; PG8_SCHED;
            PG8_STAGE(PG8_SB(1, 1), b3 + hstep, voffB);
            PG8_WAIT_V(6); PG8_BAR; PG8_MMA(1, 1, At, B1); PG8_BAR;
            }
        }
        if constexpr (ALIGN_EPI) { if (wr == 0) PG8_BAR; }
        if constexpr (!Epi::AFTER_DRAIN) { const EpiCtx ctx{ui, lds, tid}; E(acc, cur, wr, wc, fr, fq, ctx); S.done(cur); }
        if (!has_next) break;
#pragma unroll
        for (int a = 0; a < 2; ++a)
#pragma unroll
            for (int b = 0; b < 2; ++b)
#pragma unroll
                for (int m = 0; m < 4; ++m)
#pragma unroll
                    for (int n = 0; n < 2; ++n) acc[a][b][m][n] = (f32x4){0.f, 0.f, 0.f, 0.f};
        cur = nxt; cA = nA; cB = nB; ++ui;
        if constexpr (ALIGN_EPI) { if (wr == 1) PG8_BAR; }
    }
    PG8_WAIT_V(0);
    if constexpr (!ALIGN_EPI) { if (wr == 0) PG8_BAR; }
    PG8_BAR;
    if constexpr (Epi::AFTER_DRAIN) { E.fused(acc, cur, wr, wc, fr, fq, lds, wid, lane); S.done(cur); }
#undef PG8_SA
#undef PG8_SB
#undef PG8_STAGE
#undef PG8_LDA
#undef PG8_LDB
#undef PG8_MMA
#undef PG8_WAIT_V
#undef PG8_WAIT_L
#undef PG8_BAR
#undef PG8_SCHED
}
}


namespace att {
#define ATT_LAS __attribute__((address_space(3)))
#define ATT_GAS __attribute__((address_space(1)))
typedef unsigned short bf16_t;
typedef short bf16x8 __attribute__((ext_vector_type(8)));
typedef short s16x4 __attribute__((ext_vector_type(4)));
typedef float f32x16 __attribute__((ext_vector_type(16)));
typedef float f32x4 __attribute__((ext_vector_type(4)));
typedef unsigned u32x4 __attribute__((ext_vector_type(4)));
typedef unsigned u32x2 __attribute__((ext_vector_type(2)));
typedef float f32x2_t __attribute__((ext_vector_type(2))); typedef __bf16 bf16x2_t __attribute__((ext_vector_type(2)));
__device__ __forceinline__ unsigned cvtpk(float lo, float hi) { f32x2_t v = {lo, hi}; bf16x2_t b = __builtin_convertvector(v, bf16x2_t); return __builtin_bit_cast(unsigned, b); }
__device__ __forceinline__ s16x4 vtr(const ATT_LAS char* p) { return __builtin_bit_cast(s16x4, __builtin_amdgcn_ds_read_tr16_b64_v4i16((ATT_LAS s16x4*)p)); }
__device__ __forceinline__ float max3f(float x, float y, float z) { float r; asm("v_max3_f32 %0, %1, %2, %3" : "=v"(r) : "v"(x), "v"(y), "v"(z)); return r; }
__device__ __forceinline__ int crow(int r, int hi) { return (r & 3) + 8 * (r >> 2) + 4 * hi; }

constexpr int KSTR = 144, KSUB = 64 * KSTR, KBUF = 2 * KSUB;
constexpr int VBUF = 64 * 320;
constexpr int L_K = 0, L_V = 2 * KBUF, L_BIAS = L_V + 3 * VBUF, L_MISC = L_BIAS + 1056, L_Q = L_MISC + 64, L_END = L_Q + 8 * 4096;
constexpr float LOG2E = 1.4426950408889634f;
constexpr float RMS_EPS = 1e-6f;

struct Args {
    const ATT_GAS bf16_t *Qs, *Ks, *Vs, *Qm, *memK, *memV; ATT_GAS bf16_t* Ocat;
    const ATT_GAS float* relb;
    const ATT_GAS float* subln;
    float lam, one_m_li;
};

template <int KIND> __device__ __forceinline__ void attn_unit(ATT_LAS char* lds, const Args& a, int u) {
    constexpr int DV = (KIND == 1) ? 128 : 64, NDB = DV / 32, NC = (KIND == 1) ? 2 : 1, VSTR = (KIND == 1) ? 320 : 192;
    int tid_ = threadIdx.x; asm volatile("" : "+v"(tid_));
    const int tid = tid_, lane = tid & 63, r32 = lane & 31, hi = lane >> 5; const int wid = __builtin_amdgcn_readfirstlane(tid >> 6);
    int t_lo, t_hi, my_lo, my_hi, wchunk = 0, map = 0, qrow, ocol, kld, h;
    const ATT_GAS bf16_t *Qp, *Kp, *Vp;
    if (KIND == 0) {
        const int b = u / 192; h = (u >> 4) % 12; const int c0 = (u & 15) * 4;
        wchunk = c0 + (wid >> 1); qrow = b * 4096 + wchunk * 64 + (wid & 1) * 32;
        t_lo = c0 - 8 < 0 ? 0 : c0 - 8; t_hi = c0 + 3; my_lo = wchunk - 8 < 0 ? 0 : wchunk - 8; my_hi = wchunk;
        kld = 768; Qp = a.Qs + (size_t)qrow * 768 + h * 64; Kp = a.Ks + (size_t)b * 4096 * 768 + h * 64; Vp = a.Vs + (size_t)b * 4096 * 768 + h * 64; ocol = h * 64;
    } else if (KIND == 1) {
        const int qb = 31 - u / 24, bh = u % 24, b = bh / 6; h = bh % 6; const int c0 = 2 * qb, wq = wid & 3; map = wid >> 2;
        wchunk = c0 + (wq >> 1); qrow = b * 4096 + qb * 128 + wq * 32;
        t_lo = 0; t_hi = c0 + 1; my_lo = 0; my_hi = wchunk;
        kld = 768; Qp = a.Qs + (size_t)qrow * 768 + (h * 2 + map) * 64; Kp = a.Ks + (size_t)b * 4096 * 768 + h * 128; Vp = a.Vs + (size_t)b * 4096 * 768 + h * 128; ocol = h * 128;
    } else {
        const int b = u >> 6; h = (u >> 4) & 3; const int g = u & 15;
        qrow = b * 4096 + g * 256 + wid * 32; t_lo = 0; t_hi = 3; my_lo = 0; my_hi = 3;
        kld = 256; Qp = a.Qm + (size_t)qrow * 256 + h * 64; Kp = a.memK + (size_t)b * 256 * 256 + h * 64; Vp = a.memV + (size_t)b * 256 * 256 + h * 64; ocol = 768 + h * 64;
    }
    size_t ksrc[NC], vsrc[NC]; int kdst[NC], vdst[NC];
#pragma unroll
    for (int i = 0; i < NC; ++i) {
        if (KIND == 1) {
            ksrc[i] = (size_t)(tid >> 3) * 768 + i * 64 + (tid & 7) * 8; kdst[i] = i * KSUB + (tid >> 3) * KSTR + (tid & 7) * 16;
            const int key = (tid >> 4) + 32 * i; vsrc[i] = (size_t)key * 768 + (tid & 15) * 8; vdst[i] = key * VSTR + (tid & 15) * 16;
        } else {
            ksrc[i] = (size_t)(tid >> 3) * kld + (tid & 7) * 8; kdst[i] = (tid >> 3) * KSTR + (tid & 7) * 16;
            vsrc[i] = ksrc[i]; vdst[i] = (tid >> 3) * VSTR + (tid & 7) * 16;
        }
    }
    u32x4 kreg[NC], vreg[NC];
#define ATT_GLOAD(t) do { const size_t to_ = (size_t)(t) * 64 * kld; _Pragma("unroll") for (int i = 0; i < NC; ++i) { kreg[i] = *(const ATT_GAS u32x4*)(Kp + to_ + ksrc[i]); vreg[i] = *(const ATT_GAS u32x4*)(Vp + to_ + vsrc[i]); } } while (0)
#define ATT_LSTORE(kb_, vb_) do { _Pragma("unroll") for (int i = 0; i < NC; ++i) { *(ATT_LAS u32x4*)(lds + L_K + (kb_) * KBUF + kdst[i]) = kreg[i]; *(ATT_LAS u32x4*)(lds + L_V + (vb_) * VBUF + vdst[i]) = vreg[i]; } } while (0)
    ATT_GLOAD(t_lo);
    ATT_LAS float* bt = (ATT_LAS float*)(lds + L_BIAS);
    if (KIND == 0) { if (tid < 257) bt[tid] = a.relb[h * 257 + tid] * LOG2E; }
    bf16x8 qr[4];
#pragma unroll
    for (int s = 0; s < 4; ++s) qr[s] = *(const ATT_GAS bf16x8*)(Qp + (size_t)r32 * kld + 16 * s + 8 * hi);
    asm volatile("" : "+v"(qr[0]), "+v"(qr[1]), "+v"(qr[2]), "+v"(qr[3]));
    ATT_LAS bf16x8* qlds = (ATT_LAS bf16x8*)(lds + L_Q + wid * 4096) + lane;
    if (KIND == 1) {
#pragma unroll
        for (int s = 0; s < 4; ++s) qlds[64 * s] = qr[s];
    }
    f32x16 o[NDB];
#pragma unroll
    for (int db = 0; db < NDB; ++db)
#pragma unroll
        for (int r = 0; r < 16; ++r) o[db][r] = 0.f;
    float mrun = 0.f, lrun = 0.f; bool first = true;
    f32x16 negm;
#pragma unroll
    for (int r = 0; r < 16; ++r) negm[r] = 0.f;
    ATT_LSTORE(0, 0);
    if (t_lo < t_hi) ATT_GLOAD(t_lo + 1);
    asm volatile("s_waitcnt lgkmcnt(0)\n\ts_barrier" ::: "memory");
    const int g16 = lane >> 4, i16 = lane & 15;
    const int voff = (4 * hi + (i16 >> 2)) * VSTR + (16 * (g16 & 1) + 4 * (i16 & 3)) * 2;
    const bool grpB = wid >= 4;
    f32x16 negc;
    { const float cb0 = (KIND == 0) ? bt[256] : 0.f;
#pragma unroll
      for (int r = 0; r < 16; ++r) negc[r] = cb0; }
    bf16x8 pf[2][2];
    int pend = -1, vb = 0;
#define ATT_PV(vslot) do { const ATT_LAS char* vt_ = lds + L_V + (vslot) * VBUF + voff; \
        _Pragma("unroll") for (int kb = 0; kb < 2; ++kb) _Pragma("unroll") for (int s = 0; s < 2; ++s) _Pragma("unroll") for (int db = 0; db < NDB; ++db) { \
            const ATT_LAS char* vp = vt_ + (32 * kb + 16 * s) * VSTR + db * 64; const s16x4 lo = vtr(vp), hi4 = vtr(vp + 8 * VSTR); \
            const bf16x8 vf = (bf16x8){lo[0], lo[1], lo[2], lo[3], hi4[0], hi4[1], hi4[2], hi4[3]}; \
            o[db] = __builtin_amdgcn_mfma_f32_32x32x16_bf16(vf, pf[kb][s], o[db], 0, 0, 0); } } while (0)
#pragma unroll 1
    for (int t = t_lo; t <= t_hi; ++t) {
        const int buf = (t - t_lo) & 1;
        if (pend >= 0) { ATT_PV(pend); pend = -1; }
        if (t >= my_lo && t <= my_hi) {
            const ATT_LAS char* kt = lds + L_K + buf * KBUF + (KIND == 1 ? map * KSUB : 0);
            f32x16 p0, p1;
#define ATT_QK(CINIT) do { _Pragma("unroll") for (int s = 0; s < 4; ++s) { \
                const bf16x8 k0 = *(const ATT_LAS bf16x8*)(kt + r32 * KSTR + s * 32 + hi * 16); \
                const bf16x8 k1 = *(const ATT_LAS bf16x8*)(kt + (r32 + 32) * KSTR + s * 32 + hi * 16); \
                const bf16x8 qf = (KIND == 1) ? qlds[64 * s] : qr[s]; \
                if (s == 0) { p0 = __builtin_amdgcn_mfma_f32_32x32x16_bf16(k0, qf, CINIT, 0, 0, 0); p1 = __builtin_amdgcn_mfma_f32_32x32x16_bf16(k1, qf, CINIT, 0, 0, 0); } \
                else { p0 = __builtin_amdgcn_mfma_f32_32x32x16_bf16(k0, qf, p0, 0, 0, 0); p1 = __builtin_amdgcn_mfma_f32_32x32x16_bf16(k1, qf, p1, 0, 0, 0); } } } while (0)
            const bool farb = (KIND == 0) && (wchunk - t >= 3);
            if (farb) ATT_QK(negc); else ATT_QK(negm);
#undef ATT_QK
            asm volatile("s_nop 15\n\ts_nop 7" : "+v"(p0), "+v"(p1));
            if (KIND == 0) {
                const int j = wchunk - t;
                if (j < 3) {
                    const int base = 128 + 64 * j + 32 * (wid & 1) + r32 - 4 * hi;
#pragma unroll
                    for (int r = 0; r < 16; ++r) {
                        int i0 = base - ((r & 3) + 8 * (r >> 2)); int i1 = i0 - 32;
                        i0 = i0 > 256 ? 256 : i0; i1 = i1 > 256 ? 256 : i1;
                        p0[r] += bt[i0]; p1[r] += bt[i1];
                    }
                }
            }
            float mx = max3f(p0[0], p1[0], p0[1]);
#pragma unroll
            for (int r = 1; r < 15; r += 2) { mx = max3f(mx, p1[r], p0[r + 1]); }
#pragma unroll
            for (int r = 2; r < 16; r += 2) { mx = max3f(mx, p1[r], (r + 1 < 16) ? p0[r + 1] : p1[r]); }
            mx = fmaxf(fmaxf(mx, p1[15]), p0[15]);
            { auto rr = __builtin_amdgcn_permlane32_swap(__float_as_uint(mx), __float_as_uint(mx), false, false);
              mx = fmaxf(fmaxf(__uint_as_float(rr[0]), __uint_as_float(rr[1])), mx); }
            if (first || __any(mx > 8.0f)) {
                const float dl = first ? mx : fmaxf(mx, 0.f);
                first = false;
                mrun += dl;
#pragma unroll
                for (int r = 0; r < 16; ++r) { p0[r] -= dl; p1[r] -= dl; negm[r] = -mrun; if (KIND == 0) negc[r] = bt[256] - mrun; }
                const float alpha = __builtin_amdgcn_exp2f(-dl);
                lrun *= alpha;
#pragma unroll
                for (int db = 0; db < NDB; ++db)
#pragma unroll
                    for (int r = 0; r < 16; ++r) o[db][r] *= alpha;
            }
            float rs0 = 0.f, rs1 = 0.f;
#pragma unroll
            for (int r = 0; r < 16; ++r) { p0[r] = __builtin_amdgcn_exp2f(p0[r]); p1[r] = __builtin_amdgcn_exp2f(p1[r]); rs0 += p0[r]; rs1 += p1[r]; }
            lrun += rs0 + rs1;
#pragma unroll
            for (int s = 0; s < 2; ++s) {
                u32x4 w0, w1;
                w0.x = cvtpk(p0[8 * s + 0], p0[8 * s + 1]); w0.y = cvtpk(p0[8 * s + 2], p0[8 * s + 3]); w0.z = cvtpk(p0[8 * s + 4], p0[8 * s + 5]); w0.w = cvtpk(p0[8 * s + 6], p0[8 * s + 7]);
                w1.x = cvtpk(p1[8 * s + 0], p1[8 * s + 1]); w1.y = cvtpk(p1[8 * s + 2], p1[8 * s + 3]); w1.z = cvtpk(p1[8 * s + 4], p1[8 * s + 5]); w1.w = cvtpk(p1[8 * s + 6], p1[8 * s + 7]);
                pf[0][s] = __builtin_bit_cast(bf16x8, w0); pf[1][s] = __builtin_bit_cast(bf16x8, w1);
            }
            if (grpB) pend = vb; else ATT_PV(vb);
        }
        const int vn = (vb == 2) ? 0 : vb + 1;
        if (t < t_hi) ATT_LSTORE(buf ^ 1, vn);
        if (t + 1 < t_hi) ATT_GLOAD(t + 2);
        vb = vn;
        asm volatile("s_waitcnt lgkmcnt(0)\n\ts_barrier" ::: "memory");
    }
    if (pend >= 0) ATT_PV(pend);
    if (KIND == 1) __syncthreads();
#undef ATT_PV
#undef ATT_GLOAD
#undef ATT_LSTORE
    const float ltot = lrun + __shfl_xor(lrun, 32), inv = 1.0f / ltot;
    if (KIND != 1) {
        ATT_GAS bf16_t* op = a.Ocat + (size_t)(qrow + r32) * 1024 + ocol + 4 * hi;
#pragma unroll
        for (int db = 0; db < NDB; ++db)
#pragma unroll
            for (int g4 = 0; g4 < 4; ++g4) {
                u32x2 w; w.x = cvtpk(o[db][4 * g4 + 0] * inv, o[db][4 * g4 + 1] * inv); w.y = cvtpk(o[db][4 * g4 + 2] * inv, o[db][4 * g4 + 3] * inv);
                *(ATT_GAS u32x2*)(op + 32 * db + 8 * g4) = w;
            }
    } else {
        ATT_LAS float* ex = (ATT_LAS float*)lds + (wid & 3) * 4096;
        if (map == 1) {
#pragma unroll
            for (int db = 0; db < NDB; ++db)
#pragma unroll
                for (int r = 0; r < 16; ++r) ex[(db * 16 + r) * 64 + lane] = o[db][r] * inv;
        }
        __syncthreads();
        if (map == 0) {
            float sq = 0.f;
#pragma unroll
            for (int db = 0; db < NDB; ++db)
#pragma unroll
                for (int r = 0; r < 16; ++r) { const float v = o[db][r] * inv - a.lam * ex[(db * 16 + r) * 64 + lane]; o[db][r] = v; sq += v * v; }
            sq += __shfl_xor(sq, 32);
            const float rsn = rsqrtf(sq * (1.0f / 128.0f) + RMS_EPS) * a.one_m_li;
            ATT_GAS bf16_t* op = a.Ocat + (size_t)(qrow + r32) * 1024 + ocol + 4 * hi;
#pragma unroll
            for (int db = 0; db < NDB; ++db)
#pragma unroll
                for (int g4 = 0; g4 < 4; ++g4) {
                    const f32x4 gn = *(const ATT_GAS f32x4*)(a.subln + 32 * db + 8 * g4 + 4 * hi);
                    u32x2 w; w.x = cvtpk(o[db][4 * g4 + 0] * rsn * gn[0], o[db][4 * g4 + 1] * rsn * gn[1]); w.y = cvtpk(o[db][4 * g4 + 2] * rsn * gn[2], o[db][4 * g4 + 3] * rsn * gn[3]);
                    *(ATT_GAS u32x2*)(op + 32 * db + 8 * g4) = w;
                }
        }
        __syncthreads();
    }
}

__device__ __forceinline__ void attn_phase(ATT_LAS char* lds, const Args& a, int is_b, ATT_GAS unsigned* ctr) {
    volatile ATT_LAS int* misc = (volatile ATT_LAS int*)(lds + L_MISC);
    for (;;) {
        __syncthreads();
        if (threadIdx.x == 0) misc[0] = (int)__hip_atomic_fetch_add(ctr, 1u, __ATOMIC_RELAXED, __HIP_MEMORY_SCOPE_AGENT);
        __syncthreads();
        const int u = __builtin_amdgcn_readfirstlane(misc[0]);
        if (u >= 1024) break;
        if (u < 768) {
#ifndef NO_K1
            if (is_b) attn_unit<1>(lds, a, u);
#endif
#ifndef NO_K0
            if (!is_b) attn_unit<0>(lds, a, u);
#endif
        }
#ifndef NO_K2
        else attn_unit<2>(lds, a, u - 768);
#endif
    }
}
}


#define LAS __attribute__((address_space(3)))
#ifndef PROBE_GEMM2
#define PROBE_GEMM2 0
#endif
#ifndef PROBE_ATT2
#define PROBE_ATT2 0
#endif
#ifndef PROBE_SYNC2
#define PROBE_SYNC2 0
#endif
typedef unsigned short bf16;
typedef float f32x4 __attribute__((ext_vector_type(4)));
typedef unsigned v4u __attribute__((ext_vector_type(4)));
typedef unsigned v2u __attribute__((ext_vector_type(2)));

constexpr int DMODEL = 1024, NBATCH = 4, SEQ = 4096, DEPTH = 4, MTOK = NBATCH * SEQ, DFF = 2816, NMEM = 256, MROWS = NBATCH * NMEM;
constexpr int INW = 2560, SELFW = 768, MEMW = 256;
constexpr int NWAVES = 8;
constexpr size_t MiB = 1u << 20;
constexpr size_t WS_CTL = 0;
constexpr size_t WS_SS = 13 * MiB;
constexpr size_t WS_MRSTD = 2 * MiB;
constexpr size_t WS_COS = 3 * MiB, WS_SIN = 5 * MiB;
constexpr size_t WS_MEMB = 7 * MiB;
constexpr size_t WS_MEMKV = 9 * MiB;
constexpr size_t WS_XB = 16 * MiB;
constexpr size_t WS_W = 48 * MiB, W_LAYER = 41 * MiB;
constexpr size_t WO_GU1 = 0, WO_D1 = 11 * MiB, WO_IN = WO_D1 + 5632 * 1024, WO_MKV = WO_IN + 5 * MiB, WO_OUT = WO_MKV + 1 * MiB, WO_GU2 = WO_OUT + 2 * MiB, WO_D2 = WO_GU2 + 11 * MiB;
static_assert(WO_D2 + 5632 * 1024 == W_LAYER, "weight map");
constexpr size_t WS_ACT = WS_W + DEPTH * W_LAYER;
constexpr size_t AO_Q = 0, AO_K = 24 * MiB, AO_V = 48 * MiB, AO_QM = 72 * MiB, AO_O = 80 * MiB, ACT_BYTES = 112 * MiB;
constexpr size_t WS_XL = WS_ACT + ACT_BYTES;
constexpr size_t WS_END = WS_XL + 32 * MiB;
constexpr int LDS_BYTES = 151552;

struct KArgs { const void* in[28]; float* out; unsigned char* ws; int op_lo, op_hi; };

__device__ __forceinline__ unsigned f2bf(float f) { unsigned u = __builtin_bit_cast(unsigned, f); return (u + 0x7fffu + ((u >> 16) & 1u)) >> 16; }
__device__ __forceinline__ unsigned pk2(float lo, float hi) { return f2bf(lo) | (f2bf(hi) << 16); }
__device__ __forceinline__ float wave_sum(float v) {
#pragma unroll
    for (int o = 1; o < 64; o <<= 1) v += __shfl_xor(v, o);
    return v;
}
__device__ __forceinline__ void transpose_item(const float* W, int K, int N, bf16* WT, const float* gain, LAS float* scr, int item, int lane, int mode) {
    const int nblk = N / 32, kb = item / nblk, nb = item % nblk, k0 = 64 * kb, n0 = 32 * nb;
    int drow0;
    if (mode == 0) drow0 = n0;
    else if (mode == 1) drow0 = 256 * (n0 >> 7) + (n0 & 127);
    else if (mode == 2) drow0 = 256 * (n0 >> 7) + 128 + (n0 & 127);
    else drow0 = 256 * (n0 >> 8) + 128 * ((n0 >> 5) & 1) + 32 * ((n0 >> 6) & 3);
    const int q = lane & 7, r = lane >> 3;
    f32x4 v[8];
#pragma unroll
    for (int i = 0; i < 8; ++i) v[i] = *(const f32x4*)(W + (size_t)(k0 + 8 * i + r) * N + n0 + 4 * q);
    if (gain) {
#pragma unroll
        for (int i = 0; i < 8; ++i) v[i] = v[i] * gain[k0 + 8 * i + r];
    }
#pragma unroll
    for (int i = 0; i < 8; ++i) { LAS float* s = scr + (8 * i + r) * 33 + 4 * q; s[0] = v[i][0]; s[1] = v[i][1]; s[2] = v[i][2]; s[3] = v[i][3]; }
    asm volatile("s_waitcnt lgkmcnt(0)" ::: "memory");
    const int c = lane & 7;
#pragma unroll
    for (int j = 0; j < 4; ++j) { const int n = (lane >> 3) + 8 * j; const LAS float* s = scr + (8 * c) * 33 + n;
        v4u o; o.x = pk2(s[0 * 33], s[1 * 33]); o.y = pk2(s[2 * 33], s[3 * 33]); o.z = pk2(s[4 * 33], s[5 * 33]); o.w = pk2(s[6 * 33], s[7 * 33]);
        *(v4u*)(WT + (size_t)(drow0 + n) * K + k0 + 8 * c) = o; }
    asm volatile("s_waitcnt lgkmcnt(0)" ::: "memory");
}

__device__ __forceinline__ void prologue(const KArgs& A, LAS unsigned char* lds, int tid, int lane, int wave) {
    unsigned char* ws = A.ws;
    LAS float* scr = (LAS float*)(lds + wave * 8448);
    const int G = gridDim.x, gw = blockIdx.x * NWAVES + wave, NGW = G * NWAVES;
    constexpr int I_G = 16 * 88, I_D = 44 * 32, I_IN = 16 * 80, I_MKV = 16 * 16, I_OUT = 16 * 32, I_LAYER = 6 * I_G + I_IN + I_MKV + I_OUT;
    static_assert(I_G == I_D, "items");
    for (int it = gw; it < DEPTH * I_LAYER; it += NGW) {
        const int L = it / I_LAYER; int r = it % I_LAYER;
        bf16* wl = (bf16*)(ws + WS_W + (size_t)L * W_LAYER);
        const size_t o_gu = (size_t)L * DMODEL * DFF, o_n = (size_t)L * DMODEL;
        if (r < I_G) { transpose_item((const float*)A.in[4] + o_gu, DMODEL, DFF, (bf16*)((unsigned char*)wl + WO_GU1), (const float*)A.in[3] + o_n, scr, r, lane, 1); continue; } r -= I_G;
        if (r < I_G) { transpose_item((const float*)A.in[5] + o_gu, DMODEL, DFF, (bf16*)((unsigned char*)wl + WO_GU1), (const float*)A.in[3] + o_n, scr, r, lane, 2); continue; } r -= I_G;
        if (r < I_D) { transpose_item((const float*)A.in[6] + o_gu, DFF, DMODEL, (bf16*)((unsigned char*)wl + WO_D1), nullptr, scr, r, lane, 0); continue; } r -= I_D;
        if (r < I_IN) { transpose_item((const float*)A.in[9] + (size_t)L * DMODEL * INW, DMODEL, INW, (bf16*)((unsigned char*)wl + WO_IN), (const float*)A.in[7] + o_n, scr, r, lane, 3); continue; } r -= I_IN;
        if (r < I_MKV) { transpose_item((const float*)A.in[10] + (size_t)L * DMODEL * 512, DMODEL, 512, (bf16*)((unsigned char*)wl + WO_MKV), (const float*)A.in[8] + o_n, scr, r, lane, 3); continue; } r -= I_MKV;
        if (r < I_OUT) { transpose_item((const float*)A.in[13] + (size_t)L * DMODEL * DMODEL, DMODEL, DMODEL, (bf16*)((unsigned char*)wl + WO_OUT), nullptr, scr, r, lane, 0); continue; } r -= I_OUT;
        if (r < I_G) { transpose_item((const float*)A.in[25] + o_gu, DMODEL, DFF, (bf16*)((unsigned char*)wl + WO_GU2), (const float*)A.in[24] + o_n, scr, r, lane, 1); continue; } r -= I_G;
        if (r < I_G) { transpose_item((const float*)A.in[26] + o_gu, DMODEL, DFF, (bf16*)((unsigned char*)wl + WO_GU2), (const float*)A.in[24] + o_n, scr, r, lane, 2); continue; } r -= I_G;
        transpose_item((const float*)A.in[27] + o_gu, DFF, DMODEL, (bf16*)((unsigned char*)wl + WO_D2), nullptr, scr, r, lane, 0);
    }
    float* ss = (float*)(ws + WS_SS);
    for (int m = gw; m < MTOK + MROWS; m += NGW) {
        const bool ismem = m >= MTOK; const int row = ismem ? m - MTOK : m;
        const f32x4* xr = (const f32x4*)((ismem ? (const float*)A.in[1] : (const float*)A.in[0]) + (size_t)row * DMODEL) + lane;
        f32x4 v[4]; float s = 0.f;
#pragma unroll
        for (int j = 0; j < 4; ++j) { v[j] = xr[64 * j]; s += (v[j].x * v[j].x + v[j].y * v[j].y) + (v[j].z * v[j].z + v[j].w * v[j].w); }
        s = wave_sum(s);
        bf16* ob = (bf16*)(ws + (ismem ? WS_MEMB : WS_XB)) + (size_t)row * DMODEL;
        v2u hw[4];
#pragma unroll
        for (int j = 0; j < 4; ++j) { hw[j].x = pk2(v[j].x, v[j].y); hw[j].y = pk2(v[j].z, v[j].w); *((v2u*)ob + lane + 64 * j) = hw[j]; }
        if (!ismem) {
            unsigned char* ol = ws + WS_XL + (size_t)row * DMODEL;
#pragma unroll
            for (int j = 0; j < 4; ++j) {
                const float r0 = (v[j].x - __builtin_bit_cast(float, hw[j].x << 16)) * 1024.0f, r1 = (v[j].y - __builtin_bit_cast(float, hw[j].x & 0xffff0000u)) * 1024.0f;
                const float r2 = (v[j].z - __builtin_bit_cast(float, hw[j].y << 16)) * 1024.0f, r3 = (v[j].w - __builtin_bit_cast(float, hw[j].y & 0xffff0000u)) * 1024.0f;
                unsigned w = __builtin_amdgcn_cvt_pk_fp8_f32(r0, r1, 0u, false); w = __builtin_amdgcn_cvt_pk_fp8_f32(r2, r3, w, true);
                *((unsigned*)ol + lane + 64 * j) = w; }
            if (lane < 16) ss[(size_t)row * 16 + lane] = (lane == 0) ? s : 0.f;
        } else if (lane == 0) ((float*)(ws + WS_MRSTD))[row] = rsqrtf(s * (1.0f / 1024.0f) + 1e-6f);
    }
    const int gt = blockIdx.x * (NWAVES * 64) + tid, NGT = G * NWAVES * 64;
    const int* pos = (const int*)A.in[2];
    for (int e = gt; e < MTOK * 32; e += NGT) {
        const int row = e >> 5, i = e & 31;
        const float inv_freq = 1.0f / powf(10000.0f, (float)(2 * i) / 64.0f);
        const float ang = (float)pos[row] * inv_freq;
        float sn, cs; sincosf(ang, &sn, &cs);
        ((float*)(ws + WS_COS))[e] = cs; ((float*)(ws + WS_SIN))[e] = sn;
    }
}

#define XB_TMO      128
#define XB_XCNT(j)  (256  + 64 * (j))
#define XB_XSUB(j)  (1280 + 64 * (j))
#define XB_XGEN(j)  (2304 + 64 * (j))
#define XB_TOP      3328
#define XB_TOPGEN   3392
#define XCD_BAR_WORDS 3456
#define XB_SPIN_CAP (1u << 18)

__device__ __forceinline__ unsigned xb_ld(unsigned* p)              { return __hip_atomic_load(p, __ATOMIC_RELAXED, __HIP_MEMORY_SCOPE_AGENT); }
__device__ __forceinline__ unsigned xb_add(unsigned* p, unsigned v) { return __hip_atomic_fetch_add(p, v, __ATOMIC_RELAXED, __HIP_MEMORY_SCOPE_AGENT); }
__device__ __forceinline__ unsigned xb_xcc_id() { return (unsigned)__builtin_amdgcn_s_getreg((3 << 11) | 20) & 0xFu; }
#define XB_SPIN(cond, bar) do { unsigned _sp = 0; while (cond) { __builtin_amdgcn_s_sleep(1); \
    if ((++_sp & 255u) == 0u) { if (xb_ld(&(bar)[XB_TMO])) break; if (_sp > XB_SPIN_CAP) { atomicAdd(&(bar)[XB_TMO], 1u); break; } } } } while (0)

struct XcdBarrier {
    unsigned* bar; unsigned x;
    volatile LAS unsigned* st;
};

__device__ __forceinline__ XcdBarrier xcd_barrier_post(unsigned* bar, volatile LAS unsigned* st) {
    XcdBarrier b; b.bar = bar; b.x = xb_xcc_id(); b.st = st;
    if (threadIdx.x == 0) (void)xb_add(&bar[XB_XCNT(b.x)], 1u);
    return b;
}
__device__ __forceinline__ void xcd_barrier_complete(unsigned* bar, unsigned x, unsigned& nloc, unsigned& nx) {
    const unsigned G = gridDim.x * gridDim.y * gridDim.z;
    unsigned sum, cnt, mine, sp = 0u;
    for (;;) {
        sum = 0u; cnt = 0u; mine = 0u;
#pragma unroll
        for (unsigned j = 0; j < 16; ++j) { const unsigned c = xb_ld(&bar[XB_XCNT(j)]); sum += c; cnt += (c > 0u) ? 1u : 0u; mine = (j == x) ? c : mine; }
        if (sum == G) break;
        __builtin_amdgcn_s_sleep(1);
        if ((++sp & 255u) == 0u) { if (xb_ld(&bar[XB_TMO])) break; if (sp > XB_SPIN_CAP) { atomicAdd(&bar[XB_TMO], 1u); break; } }
    }
    nloc = mine > 0u ? mine : 1u; nx = cnt > 0u ? cnt : 1u;
}

__device__ __forceinline__ void xcd_barrier(const XcdBarrier& b) {
    asm volatile("s_waitcnt vmcnt(0)" ::: "memory");
    __syncthreads();
    if (threadIdx.x == 0) {
        unsigned* bar = b.bar;
        __builtin_amdgcn_s_waitcnt(0);
        unsigned nloc = b.st[0], nx = b.st[1];
        if (nloc == 0u) { xcd_barrier_complete(bar, b.x, nloc, nx); b.st[0] = nloc; b.st[1] = nx; }
        const unsigned old = xb_add(&bar[XB_XSUB(b.x)], 1u);
        const unsigned gen = old / nloc;
        if (old + 1u == (gen + 1u) * nloc) {
            __builtin_amdgcn_fence(__ATOMIC_RELEASE, "agent");
            asm volatile("s_waitcnt vmcnt(0)" ::: "memory");
            const unsigned og = xb_add(&bar[XB_TOP], 1u);
            const unsigned tg = og / nx;
            if (og + 1u == (tg + 1u) * nx) xb_add(&bar[XB_TOPGEN], 1u);
            else XB_SPIN(xb_ld(&bar[XB_TOPGEN]) == tg, bar);
            __builtin_amdgcn_fence(__ATOMIC_ACQUIRE, "agent");
            xb_add(&bar[XB_XGEN(b.x)], 1u);
            asm volatile("s_waitcnt vmcnt(0)" ::: "memory");
        } else {
            XB_SPIN(xb_ld(&bar[XB_XGEN(b.x)]) == gen, bar);
            __builtin_amdgcn_fence(__ATOMIC_ACQUIRE, "agent");
            asm volatile("s_waitcnt vmcnt(0)" ::: "memory");
        }
    }
    __syncthreads();
}

constexpr size_t WS_BAR = 128 * 1024;
constexpr int LDS_BARW = 151552 - 64;

constexpr int NOPS = 4 + 7 * DEPTH;
constexpr size_t WS_TAB = 64 * 1024;
__device__ __forceinline__ void write_table(const KArgs& A) {
    unsigned char* ws = A.ws;
    pg8::OpDesc* tab = (pg8::OpDesc*)(ws + WS_TAB);
    float* ss = (float*)(ws + WS_SS);
    bf16* XB = (bf16*)(ws + WS_XB);
    bf16* HMID = (bf16*)(ws + WS_ACT);
    bf16 *Qs = (bf16*)(ws + WS_ACT + AO_Q), *Ks = (bf16*)(ws + WS_ACT + AO_K), *Vs = (bf16*)(ws + WS_ACT + AO_V), *Qm = (bf16*)(ws + WS_ACT + AO_QM), *Ocat = (bf16*)(ws + WS_ACT + AO_O);
    const float* cosT = (const float*)(ws + WS_COS); const float* sinT = (const float*)(ws + WS_SIN);
#pragma unroll 1
    for (int op = 0; op < NOPS; ++op) {
        pg8::OpDesc* d = tab + op;
#pragma unroll
        for (int i = 0; i < 10; ++i) d->p[i] = nullptr;
        d->f[0] = 0.f; d->f[1] = 0.f; d->i[0] = 0; d->i[1] = 0;
        if (op < 4) {
            const int L = op; const unsigned char* wl = ws + WS_W + (size_t)L * W_LAYER;
            d->type = 2; d->M = MROWS; d->N = 512; d->K = DMODEL; d->A = (const bf16*)(ws + WS_MEMB); d->Bt = (const bf16*)(wl + WO_MKV);
            d->p[0] = ws + WS_MRSTD; d->p[2] = ws + WS_MEMKV + (size_t)L * MiB; d->p[3] = ws + WS_MEMKV + (size_t)L * MiB + MiB / 2; d->p[6] = (const float*)A.in[12] + L * 64;
            d->i[0] = 2; d->i[1] = 128 + 8 * L;
        } else {
            const int L = (op - 4) / 7, k = (op - 4) % 7, j2 = L >> 1; const bool isb = (L & 1) != 0;
            const unsigned char* wl = ws + WS_W + (size_t)L * W_LAYER;
            if (k == 0 || k == 5) {
                d->type = 0; d->M = MTOK; d->N = 2 * DFF; d->K = DMODEL; d->A = XB; d->Bt = (const bf16*)(wl + (k == 0 ? WO_GU1 : WO_GU2));
                d->p[0] = HMID; d->p[1] = ss + (size_t)((3 * L + (k == 0 ? 0 : 2)) % 3) * MTOK * 16;
            } else if (k == 1 || k == 4 || k == 6) {
                d->type = 1; d->M = MTOK; d->N = DMODEL; d->K = (k == 4) ? DMODEL : DFF; d->A = (k == 4) ? Ocat : HMID;
                d->Bt = (const bf16*)(wl + ((k == 1) ? WO_D1 : (k == 4 ? WO_OUT : WO_D2)));
                const int nss = 3 * L + (k == 1 ? 1 : (k == 4 ? 2 : 3));
                d->p[0] = ws + WS_XL; d->p[1] = XB; d->p[2] = ss + (size_t)(nss % 3) * MTOK * 16; d->p[3] = A.out; d->f[0] = (k == 4) ? 1.0f : 0.5f; d->i[0] = (op == NOPS - 1) ? 1 : 0;
            } else if (k == 2) {
                d->type = 2; d->M = MTOK; d->N = INW; d->K = DMODEL; d->A = XB; d->Bt = (const bf16*)(wl + WO_IN);
                d->p[0] = ss + (size_t)((3 * L + 1) % 3) * MTOK * 16; d->p[1] = Qs; d->p[2] = Ks; d->p[3] = Vs; d->p[4] = Qm;
                d->p[5] = (isb ? (const float*)A.in[17] : (const float*)A.in[14]) + j2 * 64; d->p[6] = (isb ? (const float*)A.in[18] : (const float*)A.in[15]) + j2 * 64; d->p[7] = (const float*)A.in[11] + L * 64;
                d->p[8] = cosT; d->p[9] = sinT; d->i[0] = 1 | (isb ? 4 : 0);
            } else {
                d->type = 3; d->M = 0; d->N = 0; d->K = 0; d->A = nullptr; d->Bt = nullptr;
                d->p[0] = Qs; d->p[1] = Ks; d->p[2] = Vs; d->p[3] = Qm; d->p[4] = Ocat; d->p[5] = ws + WS_MEMKV + (size_t)L * MiB; d->p[6] = ws + WS_MEMKV + (size_t)L * MiB + MiB / 2;
                d->p[7] = (const float*)A.in[16] + (size_t)j2 * 12 * 257; d->p[8] = (const float*)A.in[23] + j2 * 128; d->p[9] = (unsigned*)(ws + WS_CTL) + 16 * L;
                d->i[0] = isb ? 1 : 0; d->f[1] = 1.f;
                if (isb) {
                    const float li = 0.8f - 0.6f * expf(-0.3f * (float)L);
                    const float *q1 = (const float*)A.in[19] + j2 * 64, *k1 = (const float*)A.in[20] + j2 * 64, *q2 = (const float*)A.in[21] + j2 * 64, *k2 = (const float*)A.in[22] + j2 * 64;
                    float s1 = 0.f, s2 = 0.f;
#pragma unroll 1
                    for (int i = 0; i < 64; ++i) { s1 += q1[i] * k1[i]; s2 += q2[i] * k2[i]; }
                    d->f[0] = expf(s1) - expf(s2) + li; d->f[1] = 1.0f - li;
                }
            }
        }
    }
}

__global__ void __launch_bounds__(NWAVES * 64, 2) mega_fwd(KArgs A) {
    extern __shared__ __attribute__((aligned(16))) unsigned char lds_raw[];
    cg::grid_group grid = cg::this_grid();
    LAS unsigned char* lds = (LAS unsigned char*)lds_raw;
    const int tid = threadIdx.x, lane = tid & 63, wave = __builtin_amdgcn_readfirstlane(tid >> 6);
    if (tid < 2) ((volatile LAS unsigned*)(lds + LDS_BARW))[tid] = 0u;
    __syncthreads();
    XcdBarrier xbar = xcd_barrier_post((unsigned*)(A.ws + WS_BAR), (volatile LAS unsigned*)(lds + LDS_BARW));
    if (A.op_lo < 0) {
#ifndef NO_TAB
        if (blockIdx.x == 0 && tid == 0) write_table(A);
#endif
#ifndef NO_PRO
        prologue(A, lds, tid, lane, wave);
#endif
        if (A.op_hi > 0) xcd_barrier(xbar);
        if (A.op_hi < -5) grid.sync();
    }
    const pg8::OpDesc* tab = (const pg8::OpDesc*)(A.ws + WS_TAB);
    const int op_lo = A.op_lo < 0 ? 0 : A.op_lo, op_hi = A.op_hi;
#pragma unroll 1
    for (int op = op_lo; op < op_hi; ++op) {
        const pg8::OpDesc* d = tab + op;
        const int type = __builtin_amdgcn_readfirstlane(d->type);
        if (type == 3) {
            att::Args a;
            a.Qs = (const ATT_GAS bf16*)d->p[0]; a.Ks = (const ATT_GAS bf16*)d->p[1]; a.Vs = (const ATT_GAS bf16*)d->p[2]; a.Qm = (const ATT_GAS bf16*)d->p[3]; a.Ocat = (ATT_GAS bf16*)d->p[4];
            a.memK = (const ATT_GAS bf16*)d->p[5]; a.memV = (const ATT_GAS bf16*)d->p[6]; a.relb = (const ATT_GAS float*)d->p[7]; a.subln = (const ATT_GAS float*)d->p[8];
            a.lam = d->f[0]; a.one_m_li = d->f[1];
#ifndef NO_ATT
            att::attn_phase((__attribute__((address_space(3))) char*)lds, a, d->i[0], (ATT_GAS unsigned*)d->p[9]);
#if PROBE_ATT2
            xcd_barrier(xbar);
            att::attn_phase((__attribute__((address_space(3))) char*)lds, a, d->i[0], (ATT_GAS unsigned*)d->p[9] + 8);
#endif
#endif
        } else {
            const int G = gridDim.x, bx = blockIdx.x;
            pg8::Gemm g{(const pg8::bf16_t*)(const ATT_GAS pg8::bf16_t*)d->A, (const pg8::bf16_t*)(const ATT_GAS pg8::bf16_t*)d->Bt, d->M, d->N, d->K};
            pg8::StaticOrder S; S.init(d->M, d->N, G, (((bx - d->i[1]) % G) + G) % G);
#if PROBE_GEMM2
            for (int rep = ((PROBE_GEMM2 >> type) & 1) ? 0 : 1; rep < 2; ++rep) {
            if (rep == 1 && ((PROBE_GEMM2 >> type) & 1)) xcd_barrier(xbar);
#endif
#ifndef NO_GU
            if (type == 0) { pg8::EpiGateUp E{d}; pg8::gemm_phase<pg8::EpiGateUp, pg8::StaticOrder, true, true>(lds, g, S, E); }
#endif
#ifndef NO_RES
#if PROBE_GEMM2
            const float smul = (rep == 0) ? 0.f : 1.f;
#else
            const float smul = 1.f;
#endif
            if (type == 1) { pg8::EpiResid E{d, smul}; pg8::gemm_phase<pg8::EpiResid, pg8::StaticOrder, true, true>(lds, g, S, E); }
#endif
#ifndef NO_PROJ
            if (type == 2) { pg8::EpiProj E{d}; pg8::gemm_phase<pg8::EpiProj, pg8::StaticOrder, true, true>(lds, g, S, E); }
#endif
#if PROBE_GEMM2
            }
#endif
        }
        if (op >= 4 && op + 1 < op_hi) xcd_barrier(xbar);
#if PROBE_SYNC2
        if (op >= 4 && op + 1 < op_hi) { xcd_barrier(xbar); xcd_barrier(xbar); xcd_barrier(xbar); xcd_barrier(xbar); }
#endif
    }
}

extern "C" void kernel_launch(void* const* d_in, const int* in_sizes, int n_in, void* d_out, int out_size, void* d_ws, size_t ws_size, hipStream_t stream) {
    static int grid = 0;
    if (grid == 0) {
        if (n_in != 28 || out_size != MTOK * DMODEL || ws_size < WS_END) { fprintf(stderr, "kernel_launch: unexpected problem (n_in %d, out %d, ws %zu < %zu)\n", n_in, out_size, ws_size, (size_t)WS_END); grid = -1; return; }
        int dev = 0, cus = 0, per_cu = 0;
        hipGetDevice(&dev); hipDeviceGetAttribute(&cus, hipDeviceAttributeMultiprocessorCount, dev);
        if (hipFuncSetAttribute((const void*)mega_fwd, hipFuncAttributeMaxDynamicSharedMemorySize, LDS_BYTES) != hipSuccess) { fprintf(stderr, "kernel_launch: hipFuncSetAttribute failed\n"); grid = -1; return; }
        if (hipOccupancyMaxActiveBlocksPerMultiprocessor(&per_cu, (const void*)mega_fwd, NWAVES * 64, LDS_BYTES) != hipSuccess || per_cu < 1) { fprintf(stderr, "kernel_launch: occupancy query gives %d\n", per_cu); per_cu = 1; }
        (void)hipGetLastError();
        grid = cus * per_cu;
        fprintf(stderr, "kernel_launch: grid %d (cus %d x %d)\n", grid, cus, per_cu);
    }
    if (grid < 0) return;
    if (hipMemsetAsync((char*)d_ws + WS_CTL, 0, 256 * 1024, stream) != hipSuccess) { fprintf(stderr, "kernel_launch: memset failed\n"); return; }
    KArgs a{};
    for (int i = 0; i < 28; ++i) a.in[i] = d_in[i];
    a.out = (float*)d_out; a.ws = (unsigned char*)d_ws; a.op_lo = -1; a.op_hi = NOPS;
    void* params[] = {&a};
    hipError_t e = hipLaunchCooperativeKernel((const void*)mega_fwd, dim3(grid), dim3(NWAVES * 64), params, LDS_BYTES, stream);
    if (e != hipSuccess) fprintf(stderr, "kernel_launch: cooperative launch failed: %s (grid %d)\n", hipGetErrorString(e), grid);
}
```

```cpp
#include <hip/hip_runtime.h>
#include <hip/hip_cooperative_groups.h>
#include <cstdio>
#include <cstdint>
namespace cg = cooperative_groups;

namespace pg8 {
#define PG8_LAS __attribute__((address_space(3)))
typedef unsigned short bf16_t;
typedef short bf16x8 __attribute__((ext_vector_type(8)));
typedef float f32x4 __attribute__((ext_vector_type(4)));
typedef unsigned u32x4 __attribute__((ext_vector_type(4)));
constexpr int BM = 256, BK = 64, HALF = 128, HTB = HALF * BK * 2  , STAGE_BYTES = 8 * HTB, NXCD = 8, WGM = 8;

__host__ __device__ __forceinline__ int lds_byte(int r, int c) { const int st = (r >> 4) * 2 + (c >> 5), rr = r & 15, cc = c & 31, ob = rr * 64 + cc * 2; return st * 1024 + (ob ^ (((ob >> 9) & 1) << 5)); }
__host__ __device__ __forceinline__ void stage_rc(int b, int& R, int& C) { const int st = b / 1024, sb = b % 1024, swz = sb ^ (((sb >> 9) & 1) << 5); R = (st >> 1) * 16 + swz / 64; C = (st & 1) * 32 + (swz % 64) / 2; }
__host__ __device__ __forceinline__ int perm32(int rho) { const int n = rho >> 4, i = rho & 15; return 8 * (i >> 2) + 4 * n + (i & 3); }

struct Unit { int pm, pn; };
struct Gemm { const bf16_t* A; const bf16_t* Bt; int M, N, K; };

struct StaticOrder {
    int nM, nN, nwg, G, c;
    __host__ __device__ void init(int M, int N, int G_, int c_) { nM = M / BM; nN = N / BM; nwg = nM * nN; G = G_; c = c_; }
    __host__ __device__ bool next(int i, Unit& u) const {
        const long L = (long)i * G + c; if (L >= nwg) return false;
        int wgid = (int)L; { const int q = nwg / NXCD, r = nwg % NXCD, xcd = wgid % NXCD, off = wgid / NXCD; wgid = (xcd < r ? xcd * (q + 1) : r * (q + 1) + (xcd - r) * q) + off; }
        const int nig = WGM * nN, gid = wgid / nig, fm = gid * WGM, gsz = (nM - fm) < WGM ? (nM - fm) : WGM;
        u.pm = fm + ((wgid % nig) % gsz); u.pn = (wgid % nig) / gsz; return true;
    }
    __device__ __forceinline__ void a_ready(const Unit&) const {}
    __device__ __forceinline__ void done(const Unit&) const {}
};


__device__ __forceinline__ unsigned cvt_pk_bf16(float lo, float hi) { unsigned r; asm volatile("v_cvt_pk_bf16_f32 %0, %1, %2" : "=v"(r) : "v"(lo), "v"(hi)); return r; }
typedef float f32x2 __attribute__((ext_vector_type(2)));


#define PG8_GAS __attribute__((address_space(1)))
constexpr float RMS_EPS = 1e-6f;
constexpr float QK_C2 = 0.125f * 1.4426950408889634f;
__device__ __forceinline__ float fast_silu(float g) { return g * __builtin_amdgcn_rcpf(1.0f + __builtin_amdgcn_exp2f(-1.4426950408889634f * g)); }


struct OpDesc {
    int type, M, N, K;
    const bf16_t* A; const bf16_t* Bt;
    const void* p[10];
    float f[2]; int i[2];
};
static_assert(sizeof(OpDesc) == 128, "OpDesc");

__device__ __forceinline__ void row_rstd8(const PG8_GAS float* ssp, int row0, int fq, float (&rstd)[8]) {
    f32x4 t[8];
#pragma unroll
    for (int i = 0; i < 8; ++i) t[i] = *(const PG8_GAS f32x4*)(ssp + (size_t)(row0 + (i >> 2) * HALF + (i & 3) * 16) * 16 + 4 * fq);
#pragma unroll
    for (int i = 0; i < 8; ++i) { float s = (t[i][0] + t[i][1]) + (t[i][2] + t[i][3]); s += __shfl_xor(s, 16); s += __shfl_xor(s, 32); rstd[i] = rsqrtf(s * (1.0f / 1024.0f) + RMS_EPS); }
}

__device__ __forceinline__ void row_ms8(const PG8_GAS float* ssp, int row0, int fq, float (&ms)[8]) {
    f32x4 t[8];
#pragma unroll
    for (int i = 0; i < 8; ++i) t[i] = *(const PG8_GAS f32x4*)(ssp + (size_t)(row0 + (i >> 2) * HALF + (i & 3) * 16) * 16 + 4 * fq);
#pragma unroll
    for (int i = 0; i < 8; ++i) { float s = (t[i][0] + t[i][1]) + (t[i][2] + t[i][3]); s += __shfl_xor(s, 16); s += __shfl_xor(s, 32); ms[i] = s * (1.0f / 1024.0f) + RMS_EPS; }
}

struct EpiCtx { int ui; PG8_LAS unsigned char* lds; int tid; };
constexpr int STAT_OFF = STAGE_BYTES + 1024;

struct EpiGateUp {
    static constexpr bool PERM = true, AFTER_DRAIN = false;
    const OpDesc* d;
    __device__ __forceinline__ void operator()(const f32x4 (&acc)[2][2][4][2], const Unit& u, int wr, int wc, int fr, int fq, const EpiCtx& c) const {
        PG8_GAS bf16_t* H = (PG8_GAS bf16_t*)d->p[0]; const PG8_GAS float* ss = (const PG8_GAS float*)d->p[1]; const int ldh = 2816;
        const int row0 = u.pm * BM + wr * 64 + fr, col0 = u.pn * HALF + wc * 32 + 8 * fq;
        float ms8[8];
        PG8_LAS float* slot = (PG8_LAS float*)(c.lds + STAT_OFF) + c.tid;
        PG8_LAS int* pmslot = (PG8_LAS int*)(slot + 8 * 512);
        if (c.ui == 0 || pmslot[0] != u.pm) { row_ms8(ss, row0, fq, ms8); pmslot[0] = u.pm;
#pragma unroll
            for (int i = 0; i < 8; ++i) slot[i * 512] = ms8[i]; }
        else {
#pragma unroll
            for (int i = 0; i < 8; ++i) ms8[i] = slot[i * 512];
        }
#pragma unroll
        for (int ai = 0; ai < 2; ++ai)
#pragma unroll
            for (int m = 0; m < 4; ++m) {
                const int row = row0 + ai * HALF + m * 16;
                const float ms = ms8[ai * 4 + m], c = -1.4426950408889634f * rsqrtf(ms);
                float hv[8];
#pragma unroll
                for (int n = 0; n < 2; ++n)
#pragma unroll
                    for (int jp = 0; jp < 2; ++jp) {
                        const f32x2 g = (f32x2){acc[ai][0][m][n][2 * jp], acc[ai][0][m][n][2 * jp + 1]}, uu = (f32x2){acc[ai][1][m][n][2 * jp], acc[ai][1][m][n][2 * jp + 1]};
                        const f32x2 t = g * c; f32x2 ee; ee.x = __builtin_amdgcn_exp2f(t.x); ee.y = __builtin_amdgcn_exp2f(t.y);
                        const f32x2 dd = ee * ms + ms; f32x2 sg; sg.x = __builtin_amdgcn_rcpf(dd.x); sg.y = __builtin_amdgcn_rcpf(dd.y);
                        const f32x2 h = (g * uu) * sg;
                        hv[4 * n + 2 * jp] = h.x; hv[4 * n + 2 * jp + 1] = h.y; }
                u32x4 w; w.x = cvt_pk_bf16(hv[0], hv[1]); w.y = cvt_pk_bf16(hv[2], hv[3]); w.z = cvt_pk_bf16(hv[4], hv[5]); w.w = cvt_pk_bf16(hv[6], hv[7]);
                *(PG8_GAS u32x4*)(H + (size_t)row * ldh + col0) = w;
            }
    }
};

__device__ __forceinline__ float bf_lo(unsigned w) { return __builtin_bit_cast(float, w << 16); }
__device__ __forceinline__ float bf_hi(unsigned w) { return __builtin_bit_cast(float, w & 0xffff0000u); }
typedef unsigned u32x2 __attribute__((ext_vector_type(2)));
struct EpiResid {
    static constexpr bool PERM = true, AFTER_DRAIN = false;
    const OpDesc* d; float smul;
    __device__ __forceinline__ void operator()(const f32x4 (&acc)[2][2][4][2], const Unit& u, int wr, int wc, int fr, int fq, const EpiCtx&) const {
        PG8_GAS unsigned char* XL = (PG8_GAS unsigned char*)d->p[0]; PG8_GAS bf16_t* XB = (PG8_GAS bf16_t*)d->p[1]; PG8_GAS float* ssn = (PG8_GAS float*)d->p[2]; PG8_GAS float* OUT = (PG8_GAS float*)d->p[3];
        const float scale = d->f[0] * smul; const bool last = d->i[0] != 0;
        const int row0 = u.pm * BM + wr * 64 + fr, col0 = u.pn * BM + wc * 32 + 8 * fq;
        u32x4 hv[3][2]; u32x2 lv[3][2];
#define RES_LOAD(set, k_) do { const size_t o_ = (size_t)(row0 + ((k_) >> 2) * HALF + ((k_) & 3) * 16) * 1024 + col0; \
            _Pragma("unroll") for (int bj = 0; bj < 2; ++bj) { hv[set][bj] = *(const PG8_GAS u32x4*)(XB + o_ + bj * HALF); lv[set][bj] = *(const PG8_GAS u32x2*)(XL + o_ + bj * HALF); } } while (0)
        RES_LOAD(0, 0); RES_LOAD(1, 1);
#pragma unroll
        for (int k = 0; k < 8; ++k) {
            const int ai = k >> 2, m = k & 3, cur = k % 3;
            if (k + 2 < 8) RES_LOAD((k + 2) % 3, k + 2);
            const int row = row0 + ai * HALF + m * 16;
            const size_t o_ = (size_t)row * 1024 + col0;
            float sq = 0.f;
#pragma unroll
            for (int bj = 0; bj < 2; ++bj) {
                float x[8];
                const f32x2 l01 = __builtin_amdgcn_cvt_pk_f32_fp8(lv[cur][bj][0], false), l23 = __builtin_amdgcn_cvt_pk_f32_fp8(lv[cur][bj][0], true);
                const f32x2 l45 = __builtin_amdgcn_cvt_pk_f32_fp8(lv[cur][bj][1], false), l67 = __builtin_amdgcn_cvt_pk_f32_fp8(lv[cur][bj][1], true);
                const float lo8[8] = {l01[0], l01[1], l23[0], l23[1], l45[0], l45[1], l67[0], l67[1]};
#pragma unroll
                for (int q = 0; q < 4; ++q) {
                    x[2 * q] = (bf_lo(hv[cur][bj][q]) + lo8[2 * q] * (1.0f / 1024.0f)) + acc[ai][bj][m][q >> 1][(2 * q) & 3] * scale;
                    x[2 * q + 1] = (bf_hi(hv[cur][bj][q]) + lo8[2 * q + 1] * (1.0f / 1024.0f)) + acc[ai][bj][m][q >> 1][(2 * q + 1) & 3] * scale;
                }
#pragma unroll
                for (int q = 0; q < 8; ++q) sq += x[q] * x[q];
                if (last) {
                    *(PG8_GAS f32x4*)(OUT + o_ + bj * HALF) = (f32x4){x[0], x[1], x[2], x[3]}; *(PG8_GAS f32x4*)(OUT + o_ + bj * HALF + 4) = (f32x4){x[4], x[5], x[6], x[7]};
                } else {
                    u32x4 h; u32x2 l; float rr[8];
#pragma unroll
                    for (int q = 0; q < 4; ++q) { const unsigned hw = cvt_pk_bf16(x[2 * q], x[2 * q + 1]); h[q] = hw; rr[2 * q] = __builtin_amdgcn_fmed3f((x[2 * q] - bf_lo(hw)) * 1024.0f, -448.0f, 448.0f); rr[2 * q + 1] = __builtin_amdgcn_fmed3f((x[2 * q + 1] - bf_hi(hw)) * 1024.0f, -448.0f, 448.0f); }
                    l[0] = __builtin_amdgcn_cvt_pk_fp8_f32(rr[0], rr[1], 0u, false); l[0] = __builtin_amdgcn_cvt_pk_fp8_f32(rr[2], rr[3], l[0], true);
                    l[1] = __builtin_amdgcn_cvt_pk_fp8_f32(rr[4], rr[5], 0u, false); l[1] = __builtin_amdgcn_cvt_pk_fp8_f32(rr[6], rr[7], l[1], true);
                    *(PG8_GAS u32x4*)(XB + o_ + bj * HALF) = h; *(PG8_GAS u32x2*)(XL + o_ + bj * HALF) = l;
                }
            }
            sq += __shfl_xor(sq, 16); sq += __shfl_xor(sq, 32);
            if (fq == 0) ssn[(size_t)row * 16 + u.pn * 4 + wc] = sq;
        }
#undef RES_LOAD
    }
};

struct EpiProj {
    static constexpr bool PERM = true, AFTER_DRAIN = false;
    const OpDesc* d;
    __device__ __forceinline__ void operator()(const f32x4 (&acc)[2][2][4][2], const Unit& u, int wr, int wc, int fr, int fq, const EpiCtx& c) const {
        const int fl = d->i[0]; const int stat_is_ss = fl & 1, memmode = (fl >> 1) & 1, rope = (fl >> 2) & 1;
        int kind, tcol, ld;
        if (memmode) { kind = (u.pn == 0) ? 1 : 2; tcol = 0; ld = 256; }
        else { kind = u.pn < 3 ? 0 : (u.pn < 6 ? 1 : (u.pn < 9 ? 2 : 3)); tcol = (u.pn - 3 * kind) * 256; ld = (kind == 3) ? 256 : 768; }
        PG8_GAS bf16_t* out = (PG8_GAS bf16_t*)d->p[1 + kind];
        const PG8_GAS float* gp = (kind == 2) ? nullptr : (const PG8_GAS float*)d->p[kind == 3 ? 7 : 5 + kind];
        const PG8_GAS float* rowstat = (const PG8_GAS float*)d->p[0]; const PG8_GAS float* cosT = (const PG8_GAS float*)d->p[8]; const PG8_GAS float* sinT = (const PG8_GAS float*)d->p[9];
        const float sc = (kind == 0 || kind == 3) ? QK_C2 : 1.0f;
        const bool dorope = rope && kind < 2 && !memmode;
        f32x4 gv[2][2];
#pragma unroll
        for (int bj = 0; bj < 2; ++bj)
#pragma unroll
            for (int n = 0; n < 2; ++n) gv[bj][n] = gp ? *(const PG8_GAS f32x4*)(gp + 32 * bj + 8 * fq + 4 * n) : (f32x4){1.f, 1.f, 1.f, 1.f};
        const int row0 = u.pm * BM + wr * 64 + fr;
        float rstd8[8];
        PG8_LAS float* slot = (PG8_LAS float*)(c.lds + STAT_OFF) + c.tid;
        PG8_LAS int* pmslot = (PG8_LAS int*)(slot + 8 * 512);
        if (stat_is_ss && c.ui != 0 && pmslot[0] == u.pm) {
#pragma unroll
            for (int i = 0; i < 8; ++i) rstd8[i] = slot[i * 512];
        } else if (stat_is_ss) { row_rstd8(rowstat, row0, fq, rstd8); pmslot[0] = u.pm;
#pragma unroll
            for (int i = 0; i < 8; ++i) slot[i * 512] = rstd8[i]; }
        else {
#pragma unroll
            for (int i = 0; i < 8; ++i) rstd8[i] = rowstat[row0 + (i >> 2) * HALF + (i & 3) * 16];
        }
#pragma unroll
        for (int am = 0; am < 4; ++am) {
            const int ai = am >> 1;
            f32x4 cv[2][2], sv[2][2];
            if (dorope) {
#pragma unroll
                for (int m2 = 0; m2 < 2; ++m2)
#pragma unroll
                    for (int n = 0; n < 2; ++n) { const size_t o_ = (size_t)(row0 + ai * HALF + ((am & 1) * 2 + m2) * 16) * 32 + 8 * fq + 4 * n; cv[m2][n] = *(const PG8_GAS f32x4*)(cosT + o_); sv[m2][n] = *(const PG8_GAS f32x4*)(sinT + o_); }
            }
#pragma unroll
            for (int m2 = 0; m2 < 2; ++m2) {
                const int m = (am & 1) * 2 + m2;
                const int row = row0 + ai * HALF + m * 16;
                const float rs = rstd8[ai * 4 + m];
                f32x4 v[2][2];
#pragma unroll
                for (int bj = 0; bj < 2; ++bj)
#pragma unroll
                    for (int n = 0; n < 2; ++n) v[bj][n] = acc[ai][bj][m][n] * rs;
                if (gp) {
                    float sq = 0.f;
#pragma unroll
                    for (int bj = 0; bj < 2; ++bj)
#pragma unroll
                        for (int n = 0; n < 2; ++n) sq += (v[bj][n][0] * v[bj][n][0] + v[bj][n][1] * v[bj][n][1]) + (v[bj][n][2] * v[bj][n][2] + v[bj][n][3] * v[bj][n][3]);
                    sq += __shfl_xor(sq, 16); sq += __shfl_xor(sq, 32);
                    const float hr = rsqrtf(sq * (1.0f / 64.0f) + RMS_EPS);
#pragma unroll
                    for (int bj = 0; bj < 2; ++bj)
#pragma unroll
                        for (int n = 0; n < 2; ++n) v[bj][n] = v[bj][n] * hr * gv[bj][n];
                    if (dorope) {
#pragma unroll
                        for (int n = 0; n < 2; ++n) {
                            const f32x4 c = cv[m2][n], s = sv[m2][n];
                            const f32x4 x1 = v[0][n], x2 = v[1][n];
                            v[0][n] = x1 * c - x2 * s; v[1][n] = x2 * c + x1 * s;
                        }
                    }
#pragma unroll
                    for (int bj = 0; bj < 2; ++bj)
#pragma unroll
                        for (int n = 0; n < 2; ++n) v[bj][n] = v[bj][n] * sc;
                }
                PG8_GAS bf16_t* op = out + (size_t)row * ld + tcol + 64 * wc + 8 * fq;
#pragma unroll
                for (int bj = 0; bj < 2; ++bj) {
                    u32x4 w; w.x = cvt_pk_bf16(v[bj][0][0], v[bj][0][1]); w.y = cvt_pk_bf16(v[bj][0][2], v[bj][0][3]); w.z = cvt_pk_bf16(v[bj][1][0], v[bj][1][1]); w.w = cvt_pk_bf16(v[bj][1][2], v[bj][1][3]);
                    *(PG8_GAS u32x4*)(op + 32 * bj) = w;
                }
            }
        }
    }
};

template <class Epi, class Sched, bool ALIGN_EPI = false, bool SP2 = false>
__device__ __forceinline__ void gemm_phase(PG8_LAS unsigned char* lds, const Gemm g, const Sched& S, const Epi& E) {
    int tid_ = threadIdx.x; asm volatile("" : "+v"(tid_));
    const int tid = tid_, wid = __builtin_amdgcn_readfirstlane(tid >> 6), lane = tid & 63, wr = wid >> 2, wc = wid & 3, fr = lane & 15, fq = lane >> 4;
    const int K = g.K, nt = K / BK;
    unsigned voffA[2], voffB[2];
#pragma unroll
    for (int i = 0; i < 2; ++i) { int R, C; stage_rc(tid * 16 + i * 8192, R, C); const int Rb = Epi::PERM ? ((R & ~31) + perm32(R & 31)) : R;
        voffA[i] = (unsigned)(R * K + C) * 2u; voffB[i] = (unsigned)(Rb * K + C) * 2u; }
    const size_t kstep = (size_t)(BK * 2);
    const size_t hstep = (size_t)HALF * K * 2;
    const size_t tstep = 2 * hstep;
    const unsigned ldsw = (unsigned)wid * 1024u;
    const int aoff = lds_byte(wr * 64 + fr, fq * 8), boff = lds_byte(wc * 32 + fr, fq * 8);
#define PG8_SA(b, h) (((b) * 2 + (h)) * HTB)
#define PG8_SB(b, h) ((4 + (b) * 2 + (h)) * HTB)
#define PG8_STAGE(bufoff, gbase, voff) do { _Pragma("unroll") for (int _i = 0; _i < 2; ++_i) \
        __builtin_amdgcn_global_load_lds((const unsigned*)((const char*)(gbase) + (voff)[_i]), (PG8_LAS unsigned*)(lds + (bufoff) + ldsw + _i * 8192), 16, 0, 0); } while (0)
#define PG8_LDA(dst, b, h) do { _Pragma("unroll") for (int m = 0; m < 4; ++m) _Pragma("unroll") for (int k = 0; k < 2; ++k) dst[m][k] = *(const PG8_LAS bf16x8*)(lds + PG8_SA(b, h) + aoff + m * 2048 + k * 1024); } while (0)
#define PG8_LDB(dst, b, h) do { _Pragma("unroll") for (int n = 0; n < 2; ++n) _Pragma("unroll") for (int k = 0; k < 2; ++k) dst[n][k] = *(const PG8_LAS bf16x8*)(lds + PG8_SB(b, h) + boff + n * 2048 + k * 1024); } while (0)
#define PG8_MMA(ai, bj, At, Bt) do { __builtin_amdgcn_s_setprio(1); _Pragma("unroll") for (int m = 0; m < 4; ++m) _Pragma("unroll") for (int n = 0; n < 2; ++n) _Pragma("unroll") for (int k = 0; k < 2; ++k) \
        acc[ai][bj][m][n] = __builtin_amdgcn_mfma_f32_16x16x32_bf16(Bt[n][k], At[m][k], acc[ai][bj][m][n], 0, 0, 0); __builtin_amdgcn_s_setprio(0); } while (0)
#define PG8_WAIT_V(n) asm volatile("s_waitcnt vmcnt(" #n ")" ::: "memory")
#define PG8_WAIT_L(n) asm volatile("s_waitcnt lgkmcnt(" #n ")" ::: "memory")
#define PG8_BAR __builtin_amdgcn_s_barrier()
#define PG8_SCHED __builtin_amdgcn_sched_barrier(0)
    Unit cur, nxt; int ui = 0;
    if (!S.next(0, cur)) return;
    f32x4 acc[2][2][4][2];
#pragma unroll
    for (int a = 0; a < 2; ++a)
#pragma unroll
        for (int b = 0; b < 2; ++b)
#pragma unroll
            for (int m = 0; m < 4; ++m)
#pragma unroll
                for (int n = 0; n < 2; ++n) acc[a][b][m][n] = (f32x4){0.f, 0.f, 0.f, 0.f};
    bf16x8 At[4][2], B0[2][2], B1[2][2];
    const char* cA = (const char*)g.A + (size_t)cur.pm * tstep; const char* cB = (const char*)g.Bt + (size_t)cur.pn * tstep;
    S.a_ready(cur);
    if constexpr (SP2) {
        PG8_STAGE(PG8_SB(0, 0), cB, voffB); PG8_STAGE(PG8_SB(0, 1), cB + hstep, voffB); PG8_STAGE(PG8_SA(0, 0), cA, voffA); PG8_STAGE(PG8_SA(0, 1), cA + hstep, voffA);
        if (wr == 1) PG8_BAR;
        PG8_WAIT_V(2); PG8_BAR;
        PG8_STAGE(PG8_SB(1, 0), cB + kstep, voffB); PG8_STAGE(PG8_SA(1, 0), cA + kstep, voffA); PG8_STAGE(PG8_SB(1, 1), cB + hstep + kstep, voffB);
        PG8_WAIT_V(6); PG8_BAR;
    } else {
        PG8_STAGE(PG8_SB(0, 0), cB, voffB); PG8_STAGE(PG8_SA(0, 0), cA, voffA); PG8_STAGE(PG8_SB(0, 1), cB + hstep, voffB); PG8_STAGE(PG8_SA(0, 1), cA + hstep, voffA);
        if (wr == 1) PG8_BAR;
        PG8_WAIT_V(4); PG8_BAR;
        PG8_STAGE(PG8_SB(1, 0), cB + kstep, voffB); PG8_STAGE(PG8_SA(1, 0), cA + kstep, voffA); PG8_STAGE(PG8_SB(1, 1), cB + hstep + kstep, voffB);
        PG8_WAIT_V(6); PG8_BAR;
    }
    for (;;) {
        const bool has_next = S.next(ui + 1, nxt);
        const char* nA = has_next ? (const char*)g.A + (size_t)nxt.pm * tstep : cA; const char* nB = has_next ? (const char*)g.Bt + (size_t)nxt.pn * tstep : cB;
        for (int t = 0; t < nt; t += 2) {
            const bool last = (t == nt - 2);
            const char* a1 = cA + (size_t)(t + 1) * kstep;
            const char* a2 = last ? nA : cA + (size_t)(t + 2) * kstep; const char* b2 = last ? nB : cB + (size_t)(t + 2) * kstep;
            const char* a3 = a2 + kstep; const char* b3 = b2 + kstep;
            if (last && has_next) S.a_ready(nxt);
            if constexpr (SP2) {
            PG8_LDB(B0, 0, 0); PG8_LDB(B1, 0, 1); PG8_SCHED; PG8_LDA(At, 0, 0); PG8_STAGE(PG8_SA(1, 1), a1 + hstep, voffA);
            PG8_WAIT_V(8); PG8_WAIT_L(0); PG8_BAR; PG8_MMA(0, 0, At, B0); PG8_MMA(0, 1, At, B1); PG8_BAR; PG8_SCHED;
            PG8_LDA(At, 0, 1); PG8_STAGE(PG8_SB(0, 0), b2, voffB); PG8_STAGE(PG8_SB(0, 1), b2 + hstep, voffB); PG8_STAGE(PG8_SA(0, 0), a2, voffA);
            PG8_WAIT_V(8); PG8_WAIT_L(0); PG8_BAR; PG8_MMA(1, 0, At, B0); PG8_MMA(1, 1, At, B1); PG8_BAR; PG8_SCHED;
            PG8_LDB(B0, 1, 0); PG8_LDB(B1, 1, 1); PG8_SCHED; PG8_LDA(At, 1, 0); PG8_STAGE(PG8_SA(0, 1), a2 + hstep, voffA);
            PG8_WAIT_V(8); PG8_WAIT_L(0); PG8_BAR; PG8_MMA(0, 0, At, B0); PG8_MMA(0, 1, At, B1); PG8_BAR; PG8_SCHED;
            PG8_LDA(At, 1, 1); PG8_STAGE(PG8_SB(1, 0), b3, voffB); PG8_STAGE(PG8_SB(1, 1), b3 + hstep, voffB); PG8_STAGE(PG8_SA(1, 0), a3, voffA);
            PG8_WAIT_V(8); PG8_WAIT_L(0); PG8_BAR; PG8_MMA(1, 0, At, B0); PG8_MMA(1, 1, At, B1); PG8_BAR; PG8_SCHED;
            } else {
            PG8_LDB(B0, 0, 0); PG8_SCHED; PG8_LDA(At, 0, 0); PG8_STAGE(PG8_SA(1, 1), a1 + hstep, voffA);
            PG8_WAIT_L(8); PG8_BAR; PG8_WAIT_L(0); PG8_MMA(0, 0, At, B0); PG8_BAR; PG8_SCHED;
            PG8_LDB(B1, 0, 1); PG8_STAGE(PG8_SB(0, 0), b2, voffB);
            PG8_BAR; PG8_WAIT_L(0); PG8_MMA(0, 1, At, B1); PG8_BAR;
            PG8_LDA(At, 0, 1); PG8_STAGE(PG8_SA(0, 0), a2, voffA);
            PG8_BAR; PG8_WAIT_L(0); PG8_MMA(1, 0, At, B0); PG8_BAR; PG8_SCHED;
            PG8_STAGE(PG8_SB(0, 1), b2 + hstep, voffB);
            PG8_WAIT_V(6); PG8_BAR; PG8_MMA(1, 1, At, B1); PG8_BAR;
            PG8_LDB(B0, 1, 0); PG8_SCHED; PG8_LDA(At, 1, 0); PG8_STAGE(PG8_SA(0, 1), a2 + hstep, voffA);
            PG8_WAIT_L(8); PG8_BAR; PG8_WAIT_L(0); PG8_MMA(0, 0, At, B0); PG8_BAR; PG8_SCHED;
            PG8_LDB(B1, 1, 1); PG8_STAGE(PG8_SB(1, 0), b3, voffB);
            PG8_BAR; PG8_WAIT_L(0); PG8_MMA(0, 1, At, B1); PG8_BAR;
            PG8_LDA(At, 1, 1); PG8_STAGE(PG8_SA(1, 0), a3, voffA);
            PG8_BAR; PG8_WAIT_L(0); PG8_MMA(1, 0, At, B0); PG8_BAR; PG8_SCHED;
            PG8_STAGE(PG8_SB(1, 1), b3 + hstep, voffB);
            PG8_WAIT_V(6); PG8_BAR; PG8_MMA(1, 1, At, B1); PG8_BAR;
            }
        }
        if constexpr (ALIGN_EPI) { if (wr == 0) PG8_BAR; }
        if constexpr (!Epi::AFTER_DRAIN) { const EpiCtx ctx{ui, lds, tid}; E(acc, cur, wr, wc, fr, fq, ctx); S.done(cur); }
        if (!has_next) break;
#pragma unroll
        for (int a = 0; a < 2; ++a)
#pragma unroll
            for (int b = 0; b < 2; ++b)
#pragma unroll
                for (int m = 0; m < 4; ++m)
#pragma unroll
                    for (int n = 0; n < 2; ++n) acc[a][b][m][n] = (f32x4){0.f, 0.f, 0.f, 0.f};
        cur = nxt; cA = nA; cB = nB; ++ui;
        if constexpr (ALIGN_EPI) { if (wr == 1) PG8_BAR; }
    }
    PG8_WAIT_V(0);
    if constexpr (!ALIGN_EPI) { if (wr == 0) PG8_BAR; }
    PG8_BAR;
    if constexpr (Epi::AFTER_DRAIN) { E.fused(acc, cur, wr, wc, fr, fq, lds, wid, lane); S.done(cur); }
#undef PG8_SA
#undef PG8_SB
#undef PG8_STAGE
#undef PG8_LDA
#undef PG8_LDB
#undef PG8_MMA
#undef PG8_WAIT_V
#undef PG8_WAIT_L
#undef PG8_BAR
#undef PG8_SCHED
}
}


namespace att {
#define ATT_LAS __attribute__((address_space(3)))
#define ATT_GAS __attribute__((address_space(1)))
typedef unsigned short bf16_t;
typedef short bf16x8 __attribute__((ext_vector_type(8)));
typedef short s16x4 __attribute__((ext_vector_type(4)));
typedef float f32x16 __attribute__((ext_vector_type(16)));
typedef float f32x4 __attribute__((ext_vector_type(4)));
typedef unsigned u32x4 __attribute__((ext_vector_type(4)));
typedef unsigned u32x2 __attribute__((ext_vector_type(2)));
typedef float f32x2_t __attribute__((ext_vector_type(2))); typedef __bf16 bf16x2_t __attribute__((ext_vector_type(2)));
__device__ __forceinline__ unsigned cvtpk(float lo, float hi) { f32x2_t v = {lo, hi}; bf16x2_t b = __builtin_convertvector(v, bf16x2_t); return __builtin_bit_cast(unsigned, b); }
__device__ __forceinline__ s16x4 vtr(const ATT_LAS char* p) { return __builtin_bit_cast(s16x4, __builtin_amdgcn_ds_read_tr16_b64_v4i16((ATT_LAS s16x4*)p)); }
__device__ __forceinline__ float max3f(float x, float y, float z) { float r; asm("v_max3_f32 %0, %1, %2, %3" : "=v"(r) : "v"(x), "v"(y), "v"(z)); return r; }
__device__ __forceinline__ int crow(int r, int hi) { return (r & 3) + 8 * (r >> 2) + 4 * hi; }

constexpr int KSTR = 144, KSUB = 64 * KSTR, KBUF = 2 * KSUB;
constexpr int VBUF = 64 * 320;
constexpr int L_K = 0, L_V = 2 * KBUF, L_BIAS = L_V + 3 * VBUF, L_MISC = L_BIAS + 1056, L_Q = L_MISC + 64, L_END = L_Q + 8 * 4096;
constexpr float LOG2E = 1.4426950408889634f;
constexpr float RMS_EPS = 1e-6f;

struct Args {
    const ATT_GAS bf16_t *Qs, *Ks, *Vs, *Qm, *memK, *memV; ATT_GAS bf16_t* Ocat;
    const ATT_GAS float* relb;
    const ATT_GAS float* subln;
    float lam, one_m_li;
};

template <int KIND> __device__ __forceinline__ void attn_unit(ATT_LAS char* lds, const Args& a, int u) {
    constexpr int DV = (KIND == 1) ? 128 : 64, NDB = DV / 32, NC = (KIND == 1) ? 2 : 1, VSTR = (KIND == 1) ? 320 : 192;
    int tid_ = threadIdx.x; asm volatile("" : "+v"(tid_));
    const int tid = tid_, lane = tid & 63, r32 = lane & 31, hi = lane >> 5; const int wid = __builtin_amdgcn_readfirstlane(tid >> 6);
    int t_lo, t_hi, my_lo, my_hi, wchunk = 0, map = 0, qrow, ocol, kld, h;
    const ATT_GAS bf16_t *Qp, *Kp, *Vp;
    if (KIND == 0) {
        const int b = u / 192; h = (u >> 4) % 12; const int c0 = (u & 15) * 4;
        wchunk = c0 + (wid >> 1); qrow = b * 4096 + wchunk * 64 + (wid & 1) * 32;
        t_lo = c0 - 8 < 0 ? 0 : c0 - 8; t_hi = c0 + 3; my_lo = wchunk - 8 < 0 ? 0 : wchunk - 8; my_hi = wchunk;
        kld = 768; Qp = a.Qs + (size_t)qrow * 768 + h * 64; Kp = a.Ks + (size_t)b * 4096 * 768 + h * 64; Vp = a.Vs + (size_t)b * 4096 * 768 + h * 64; ocol = h * 64;
    } else if (KIND == 1) {
        const int qb = 31 - u / 24, bh = u % 24, b = bh / 6; h = bh % 6; const int c0 = 2 * qb, wq = wid & 3; map = wid >> 2;
        wchunk = c0 + (wq >> 1); qrow = b * 4096 + qb * 128 + wq * 32;
        t_lo = 0; t_hi = c0 + 1; my_lo = 0; my_hi = wchunk;
        kld = 768; Qp = a.Qs + (size_t)qrow * 768 + (h * 2 + map) * 64; Kp = a.Ks + (size_t)b * 4096 * 768 + h * 128; Vp = a.Vs + (size_t)b * 4096 * 768 + h * 128; ocol = h * 128;
    } else {
        const int b = u >> 6; h = (u >> 4) & 3; const int g = u & 15;
        qrow = b * 4096 + g * 256 + wid * 32; t_lo = 0; t_hi = 3; my_lo = 0; my_hi = 3;
        kld = 256; Qp = a.Qm + (size_t)qrow * 256 + h * 64; Kp = a.memK + (size_t)b * 256 * 256 + h * 64; Vp = a.memV + (size_t)b * 256 * 256 + h * 64; ocol = 768 + h * 64;
    }
    size_t ksrc[NC], vsrc[NC]; int kdst[NC], vdst[NC];
#pragma unroll
    for (int i = 0; i < NC; ++i) {
        if (KIND == 1) {
            ksrc[i] = (size_t)(tid >> 3) * 768 + i * 64 + (tid & 7) * 8; kdst[i] = i * KSUB + (tid >> 3) * KSTR + (tid & 7) * 16;
            const int key = (tid >> 4) + 32 * i; vsrc[i] = (size_t)key * 768 + (tid & 15) * 8; vdst[i] = key * VSTR + (tid & 15) * 16;
        } else {
            ksrc[i] = (size_t)(tid >> 3) * kld + (tid & 7) * 8; kdst[i] = (tid >> 3) * KSTR + (tid & 7) * 16;
            vsrc[i] = ksrc[i]; vdst[i] = (tid >> 3) * VSTR + (tid & 7) * 16;
        }
    }
    u32x4 kreg[NC], vreg[NC];
#define ATT_GLOAD(t) do { const size_t to_ = (size_t)(t) * 64 * kld; _Pragma("unroll") for (int i = 0; i < NC; ++i) { kreg[i] = *(const ATT_GAS u32x4*)(Kp + to_ + ksrc[i]); vreg[i] = *(const ATT_GAS u32x4*)(Vp + to_ + vsrc[i]); } } while (0)
#define ATT_LSTORE(kb_, vb_) do { _Pragma("unroll") for (int i = 0; i < NC; ++i) { *(ATT_LAS u32x4*)(lds + L_K + (kb_) * KBUF + kdst[i]) = kreg[i]; *(ATT_LAS u32x4*)(lds + L_V + (vb_) * VBUF + vdst[i]) = vreg[i]; } } while (0)
    ATT_GLOAD(t_lo);
    ATT_LAS float* bt = (ATT_LAS float*)(lds + L_BIAS);
    if (KIND == 0) { if (tid < 257) bt[tid] = a.relb[h * 257 + tid] * LOG2E; }
    bf16x8 qr[4];
#pragma unroll
    for (int s = 0; s < 4; ++s) qr[s] = *(const ATT_GAS bf16x8*)(Qp + (size_t)r32 * kld + 16 * s + 8 * hi);
    asm volatile("" : "+v"(qr[0]), "+v"(qr[1]), "+v"(qr[2]), "+v"(qr[3]));
    ATT_LAS bf16x8* qlds = (ATT_LAS bf16x8*)(lds + L_Q + wid * 4096) + lane;
    if (KIND == 1) {
#pragma unroll
        for (int s = 0; s < 4; ++s) qlds[64 * s] = qr[s];
    }
    f32x16 o[NDB];
#pragma unroll
    for (int db = 0; db < NDB; ++db)
#pragma unroll
        for (int r = 0; r < 16; ++r) o[db][r] = 0.f;
    float mrun = 0.f, lrun = 0.f; bool first = true;
    f32x16 negm;
#pragma unroll
    for (int r = 0; r < 16; ++r) negm[r] = 0.f;
    ATT_LSTORE(0, 0);
    if (t_lo < t_hi) ATT_GLOAD(t_lo + 1);
    asm volatile("s_waitcnt lgkmcnt(0)\n\ts_barrier" ::: "memory");
    const int g16 = lane >> 4, i16 = lane & 15;
    const int voff = (4 * hi + (i16 >> 2)) * VSTR + (16 * (g16 & 1) + 4 * (i16 & 3)) * 2;
    const bool grpB = wid >= 4;
    f32x16 negc;
    { const float cb0 = (KIND == 0) ? bt[256] : 0.f;
#pragma unroll
      for (int r = 0; r < 16; ++r) negc[r] = cb0; }
    bf16x8 pf[2][2];
    int pend = -1, vb = 0;
#define ATT_PV(vslot) do { const ATT_LAS char* vt_ = lds + L_V + (vslot) * VBUF + voff; \
        _Pragma("unroll") for (int kb = 0; kb < 2; ++kb) _Pragma("unroll") for (int s = 0; s < 2; ++s) _Pragma("unroll") for (int db = 0; db < NDB; ++db) { \
            const ATT_LAS char* vp = vt_ + (32 * kb + 16 * s) * VSTR + db * 64; const s16x4 lo = vtr(vp), hi4 = vtr(vp + 8 * VSTR); \
            const bf16x8 vf = (bf16x8){lo[0], lo[1], lo[2], lo[3], hi4[0], hi4[1], hi4[2], hi4[3]}; \
            o[db] = __builtin_amdgcn_mfma_f32_32x32x16_bf16(vf, pf[kb][s], o[db], 0, 0, 0); } } while (0)
#pragma unroll 1
    for (int t = t_lo; t <= t_hi; ++t) {
        const int buf = (t - t_lo) & 1;
        if (pend >= 0) { ATT_PV(pend); pend = -1; }
        if (t >= my_lo && t <= my_hi) {
            const ATT_LAS char* kt = lds + L_K + buf * KBUF + (KIND == 1 ? map * KSUB : 0);
            f32x16 p0, p1;
#define ATT_QK(CINIT) do { _Pragma("unroll") for (int s = 0; s < 4; ++s) { \
                const bf16x8 k0 = *(const ATT_LAS bf16x8*)(kt + r32 * KSTR + s * 32 + hi * 16); \
                const bf16x8 k1 = *(const ATT_LAS bf16x8*)(kt + (r32 + 32) * KSTR + s * 32 + hi * 16); \
                const bf16x8 qf = (KIND == 1) ? qlds[64 * s] : qr[s]; \
                if (s == 0) { p0 = __builtin_amdgcn_mfma_f32_32x32x16_bf16(k0, qf, CINIT, 0, 0, 0); p1 = __builtin_amdgcn_mfma_f32_32x32x16_bf16(k1, qf, CINIT, 0, 0, 0); } \
                else { p0 = __builtin_amdgcn_mfma_f32_32x32x16_bf16(k0, qf, p0, 0, 0, 0); p1 = __builtin_amdgcn_mfma_f32_32x32x16_bf16(k1, qf, p1, 0, 0, 0); } } } while (0)
            const bool farb = (KIND == 0) && (wchunk - t >= 3);
            if (farb) ATT_QK(negc); else ATT_QK(negm);
#undef ATT_QK
            asm volatile("s_nop 15\n\ts_nop 7" : "+v"(p0), "+v"(p1));
            if (KIND == 0) {
                const int j = wchunk - t;
                if (j < 3) {
                    const int base = 128 + 64 * j + 32 * (wid & 1) + r32 - 4 * hi;
#pragma unroll
                    for (int r = 0; r < 16; ++r) {
                        int i0 = base - ((r & 3) + 8 * (r >> 2)); int i1 = i0 - 32;
                        i0 = i0 > 256 ? 256 : i0; i1 = i1 > 256 ? 256 : i1;
                        p0[r] += bt[i0]; p1[r] += bt[i1];
                    }
                }
            }
            float mx = max3f(p0[0], p1[0], p0[1]);
#pragma unroll
            for (int r = 1; r < 15; r += 2) { mx = max3f(mx, p1[r], p0[r + 1]); }
#pragma unroll
            for (int r = 2; r < 16; r += 2) { mx = max3f(mx, p1[r], (r + 1 < 16) ? p0[r + 1] : p1[r]); }
            mx = fmaxf(fmaxf(mx, p1[15]), p0[15]);
            { auto rr = __builtin_amdgcn_permlane32_swap(__float_as_uint(mx), __float_as_uint(mx), false, false);
              mx = fmaxf(fmaxf(__uint_as_float(rr[0]), __uint_as_float(rr[1])), mx); }
            if (first || __any(mx > 8.0f)) {
                const float dl = first ? mx : fmaxf(mx, 0.f);
                first = false;
                mrun += dl;
#pragma unroll
                for (int r = 0; r < 16; ++r) { p0[r] -= dl; p1[r] -= dl; negm[r] = -mrun; if (KIND == 0) negc[r] = bt[256] - mrun; }
                const float alpha = __builtin_amdgcn_exp2f(-dl);
                lrun *= alpha;
#pragma unroll
                for (int db = 0; db < NDB; ++db)
#pragma unroll
                    for (int r = 0; r < 16; ++r) o[db][r] *= alpha;
            }
            float rs0 = 0.f, rs1 = 0.f;
#pragma unroll
            for (int r = 0; r < 16; ++r) { p0[r] = __builtin_amdgcn_exp2f(p0[r]); p1[r] = __builtin_amdgcn_exp2f(p1[r]); rs0 += p0[r]; rs1 += p1[r]; }
            lrun += rs0 + rs1;
#pragma unroll
            for (int s = 0; s < 2; ++s) {
                u32x4 w0, w1;
                w0.x = cvtpk(p0[8 * s + 0], p0[8 * s + 1]); w0.y = cvtpk(p0[8 * s + 2], p0[8 * s + 3]); w0.z = cvtpk(p0[8 * s + 4], p0[8 * s + 5]); w0.w = cvtpk(p0[8 * s + 6], p0[8 * s + 7]);
                w1.x = cvtpk(p1[8 * s + 0], p1[8 * s + 1]); w1.y = cvtpk(p1[8 * s + 2], p1[8 * s + 3]); w1.z = cvtpk(p1[8 * s + 4], p1[8 * s + 5]); w1.w = cvtpk(p1[8 * s + 6], p1[8 * s + 7]);
                pf[0][s] = __builtin_bit_cast(bf16x8, w0); pf[1][s] = __builtin_bit_cast(bf16x8, w1);
            }
            if (grpB) pend = vb; else ATT_PV(vb);
        }
        const int vn = (vb == 2) ? 0 : vb + 1;
        if (t < t_hi) ATT_LSTORE(buf ^ 1, vn);
        if (t + 1 < t_hi) ATT_GLOAD(t + 2);
        vb = vn;
        asm volatile("s_waitcnt lgkmcnt(0)\n\ts_barrier" ::: "memory");
    }
    if (pend >= 0) ATT_PV(pend);
    if (KIND == 1) __syncthreads();
#undef ATT_PV
#undef ATT_GLOAD
#undef ATT_LSTORE
    const float ltot = lrun + __shfl_xor(lrun, 32), inv = 1.0f / ltot;
    if (KIND != 1) {
        ATT_GAS bf16_t* op = a.Ocat + (size_t)(qrow + r32) * 1024 + ocol + 4 * hi;
#pragma unroll
        for (int db = 0; db < NDB; ++db)
#pragma unroll
            for (int g4 = 0; g4 < 4; ++g4) {
                u32x2 w; w.x = cvtpk(o[db][4 * g4 + 0] * inv, o[db][4 * g4 + 1] * inv); w.y = cvtpk(o[db][4 * g4 + 2] * inv, o[db][4 * g4 + 3] * inv);
                *(ATT_GAS u32x2*)(op + 32 * db + 8 * g4) = w;
            }
    } else {
        ATT_LAS float* ex = (ATT_LAS float*)lds + (wid & 3) * 4096;
        if (map == 1) {
#pragma unroll
            for (int db = 0; db < NDB; ++db)
#pragma unroll
                for (int r = 0; r < 16; ++r) ex[(db * 16 + r) * 64 + lane] = o[db][r] * inv;
        }
        __syncthreads();
        if (map == 0) {
            float sq = 0.f;
#pragma unroll
            for (int db = 0; db < NDB; ++db)
#pragma unroll
                for (int r = 0; r < 16; ++r) { const float v = o[db][r] * inv - a.lam * ex[(db * 16 + r) * 64 + lane]; o[db][r] = v; sq += v * v; }
            sq += __shfl_xor(sq, 32);
            const float rsn = rsqrtf(sq * (1.0f / 128.0f) + RMS_EPS) * a.one_m_li;
            ATT_GAS bf16_t* op = a.Ocat + (size_t)(qrow + r32) * 1024 + ocol + 4 * hi;
#pragma unroll
            for (int db = 0; db < NDB; ++db)
#pragma unroll
                for (int g4 = 0; g4 < 4; ++g4) {
                    const f32x4 gn = *(const ATT_GAS f32x4*)(a.subln + 32 * db + 8 * g4 + 4 * hi);
                    u32x2 w; w.x = cvtpk(o[db][4 * g4 + 0] * rsn * gn[0], o[db][4 * g4 + 1] * rsn * gn[1]); w.y = cvtpk(o[db][4 * g4 + 2] * rsn * gn[2], o[db][4 * g4 + 3] * rsn * gn[3]);
                    *(ATT_GAS u32x2*)(op + 32 * db + 8 * g4) = w;
                }
        }
        __syncthreads();
    }
}

__device__ __forceinline__ void attn_phase(ATT_LAS char* lds, const Args& a, int is_b, ATT_GAS unsigned* ctr) {
    volatile ATT_LAS int* misc = (volatile ATT_LAS int*)(lds + L_MISC);
    for (;;) {
        asm volatile("s_waitcnt lgkmcnt(0)\n\ts_barrier" ::: "memory");
        if (threadIdx.x == 0) misc[0] = (int)__hip_atomic_fetch_add(ctr, 1u, __ATOMIC_RELAXED, __HIP_MEMORY_SCOPE_AGENT);
        asm volatile("s_waitcnt lgkmcnt(0)\n\ts_barrier" ::: "memory");
        const int u = __builtin_amdgcn_readfirstlane(misc[0]);
        if (u >= 1024) break;
        if (u < 768) {
#ifndef NO_K1
            if (is_b) attn_unit<1>(lds, a, u);
#endif
#ifndef NO_K0
            if (!is_b) attn_unit<0>(lds, a, u);
#endif
        }
#ifndef NO_K2
        else attn_unit<2>(lds, a, u - 768);
#endif
    }
}
}


#define LAS __attribute__((address_space(3)))
#ifndef PROBE_GEMM2
#define PROBE_GEMM2 0
#endif
#ifndef PROBE_ATT2
#define PROBE_ATT2 0
#endif
#ifndef PROBE_SYNC2
#define PROBE_SYNC2 0
#endif
typedef unsigned short bf16;
typedef float f32x4 __attribute__((ext_vector_type(4)));
typedef unsigned v4u __attribute__((ext_vector_type(4)));
typedef unsigned v2u __attribute__((ext_vector_type(2)));

constexpr int DMODEL = 1024, NBATCH = 4, SEQ = 4096, DEPTH = 4, MTOK = NBATCH * SEQ, DFF = 2816, NMEM = 256, MROWS = NBATCH * NMEM;
constexpr int INW = 2560, SELFW = 768, MEMW = 256;
constexpr int NWAVES = 8;
constexpr size_t MiB = 1u << 20;
constexpr size_t WS_CTL = 0;
constexpr size_t WS_SS = 13 * MiB;
constexpr size_t WS_MRSTD = 2 * MiB;
constexpr size_t WS_COS = 3 * MiB, WS_SIN = 5 * MiB;
constexpr size_t WS_MEMB = 7 * MiB;
constexpr size_t WS_MEMKV = 9 * MiB;
constexpr size_t WS_XB = 16 * MiB;
constexpr size_t WS_W = 48 * MiB, W_LAYER = 41 * MiB;
constexpr size_t WO_GU1 = 0, WO_D1 = 11 * MiB, WO_IN = WO_D1 + 5632 * 1024, WO_MKV = WO_IN + 5 * MiB, WO_OUT = WO_MKV + 1 * MiB, WO_GU2 = WO_OUT + 2 * MiB, WO_D2 = WO_GU2 + 11 * MiB;
static_assert(WO_D2 + 5632 * 1024 == W_LAYER, "weight map");
constexpr size_t WS_ACT = WS_W + DEPTH * W_LAYER;
constexpr size_t AO_Q = 0, AO_K = 24 * MiB, AO_V = 48 * MiB, AO_QM = 72 * MiB, AO_O = 80 * MiB, ACT_BYTES = 112 * MiB;
constexpr size_t WS_XL = WS_ACT + ACT_BYTES;
constexpr size_t WS_END = WS_XL + 32 * MiB;
constexpr int LDS_BYTES = 151552;

struct KArgs { const void* in[28]; float* out; unsigned char* ws; int op_lo, op_hi; };

__device__ __forceinline__ unsigned f2bf(float f) { unsigned u = __builtin_bit_cast(unsigned, f); return (u + 0x7fffu + ((u >> 16) & 1u)) >> 16; }
__device__ __forceinline__ unsigned pk2(float lo, float hi) { return f2bf(lo) | (f2bf(hi) << 16); }
__device__ __forceinline__ float wave_sum(float v) {
#pragma unroll
    for (int o = 1; o < 64; o <<= 1) v += __shfl_xor(v, o);
    return v;
}
__device__ __forceinline__ void transpose_item(const float* W, int K, int N, bf16* WT, const float* gain, LAS float* scr, int item, int lane, int mode) {
    const int nblk = N / 32, kb = item / nblk, nb = item % nblk, k0 = 64 * kb, n0 = 32 * nb;
    int drow0;
    if (mode == 0) drow0 = n0;
    else if (mode == 1) drow0 = 256 * (n0 >> 7) + (n0 & 127);
    else if (mode == 2) drow0 = 256 * (n0 >> 7) + 128 + (n0 & 127);
    else drow0 = 256 * (n0 >> 8) + 128 * ((n0 >> 5) & 1) + 32 * ((n0 >> 6) & 3);
    const int q = lane & 7, r = lane >> 3;
    f32x4 v[8];
#pragma unroll
    for (int i = 0; i < 8; ++i) v[i] = *(const f32x4*)(W + (size_t)(k0 + 8 * i + r) * N + n0 + 4 * q);
    if (gain) {
#pragma unroll
        for (int i = 0; i < 8; ++i) v[i] = v[i] * gain[k0 + 8 * i + r];
    }
#pragma unroll
    for (int i = 0; i < 8; ++i) { LAS float* s = scr + (8 * i + r) * 33 + 4 * q; s[0] = v[i][0]; s[1] = v[i][1]; s[2] = v[i][2]; s[3] = v[i][3]; }
    asm volatile("s_waitcnt lgkmcnt(0)" ::: "memory");
    const int c = lane & 7;
#pragma unroll
    for (int j = 0; j < 4; ++j) { const int n = (lane >> 3) + 8 * j; const LAS float* s = scr + (8 * c) * 33 + n;
        v4u o; o.x = pk2(s[0 * 33], s[1 * 33]); o.y = pk2(s[2 * 33], s[3 * 33]); o.z = pk2(s[4 * 33], s[5 * 33]); o.w = pk2(s[6 * 33], s[7 * 33]);
        *(v4u*)(WT + (size_t)(drow0 + n) * K + k0 + 8 * c) = o; }
    asm volatile("s_waitcnt lgkmcnt(0)" ::: "memory");
}

__device__ __forceinline__ void prologue(const KArgs& A, LAS unsigned char* lds, int tid, int lane, int wave) {
    unsigned char* ws = A.ws;
    LAS float* scr = (LAS float*)(lds + wave * 8448);
    const int G = gridDim.x, gw = blockIdx.x * NWAVES + wave, NGW = G * NWAVES;
    constexpr int I_G = 16 * 88, I_D = 44 * 32, I_IN = 16 * 80, I_MKV = 16 * 16, I_OUT = 16 * 32, I_LAYER = 6 * I_G + I_IN + I_MKV + I_OUT;
    static_assert(I_G == I_D, "items");
    for (int it = gw; it < DEPTH * I_LAYER; it += NGW) {
        const int L = it / I_LAYER; int r = it % I_LAYER;
        bf16* wl = (bf16*)(ws + WS_W + (size_t)L * W_LAYER);
        const size_t o_gu = (size_t)L * DMODEL * DFF, o_n = (size_t)L * DMODEL;
        if (r < I_G) { transpose_item((const float*)A.in[4] + o_gu, DMODEL, DFF, (bf16*)((unsigned char*)wl + WO_GU1), (const float*)A.in[3] + o_n, scr, r, lane, 1); continue; } r -= I_G;
        if (r < I_G) { transpose_item((const float*)A.in[5] + o_gu, DMODEL, DFF, (bf16*)((unsigned char*)wl + WO_GU1), (const float*)A.in[3] + o_n, scr, r, lane, 2); continue; } r -= I_G;
        if (r < I_D) { transpose_item((const float*)A.in[6] + o_gu, DFF, DMODEL, (bf16*)((unsigned char*)wl + WO_D1), nullptr, scr, r, lane, 0); continue; } r -= I_D;
        if (r < I_IN) { transpose_item((const float*)A.in[9] + (size_t)L * DMODEL * INW, DMODEL, INW, (bf16*)((unsigned char*)wl + WO_IN), (const float*)A.in[7] + o_n, scr, r, lane, 3); continue; } r -= I_IN;
        if (r < I_MKV) { transpose_item((const float*)A.in[10] + (size_t)L * DMODEL * 512, DMODEL, 512, (bf16*)((unsigned char*)wl + WO_MKV), (const float*)A.in[8] + o_n, scr, r, lane, 3); continue; } r -= I_MKV;
        if (r < I_OUT) { transpose_item((const float*)A.in[13] + (size_t)L * DMODEL * DMODEL, DMODEL, DMODEL, (bf16*)((unsigned char*)wl + WO_OUT), nullptr, scr, r, lane, 0); continue; } r -= I_OUT;
        if (r < I_G) { transpose_item((const float*)A.in[25] + o_gu, DMODEL, DFF, (bf16*)((unsigned char*)wl + WO_GU2), (const float*)A.in[24] + o_n, scr, r, lane, 1); continue; } r -= I_G;
        if (r < I_G) { transpose_item((const float*)A.in[26] + o_gu, DMODEL, DFF, (bf16*)((unsigned char*)wl + WO_GU2), (const float*)A.in[24] + o_n, scr, r, lane, 2); continue; } r -= I_G;
        transpose_item((const float*)A.in[27] + o_gu, DFF, DMODEL, (bf16*)((unsigned char*)wl + WO_D2), nullptr, scr, r, lane, 0);
    }
    float* ss = (float*)(ws + WS_SS);
    for (int m = gw; m < MTOK + MROWS; m += NGW) {
        const bool ismem = m >= MTOK; const int row = ismem ? m - MTOK : m;
        const f32x4* xr = (const f32x4*)((ismem ? (const float*)A.in[1] : (const float*)A.in[0]) + (size_t)row * DMODEL) + lane;
        f32x4 v[4]; float s = 0.f;
#pragma unroll
        for (int j = 0; j < 4; ++j) { v[j] = xr[64 * j]; s += (v[j].x * v[j].x + v[j].y * v[j].y) + (v[j].z * v[j].z + v[j].w * v[j].w); }
        s = wave_sum(s);
        bf16* ob = (bf16*)(ws + (ismem ? WS_MEMB : WS_XB)) + (size_t)row * DMODEL;
        v2u hw[4];
#pragma unroll
        for (int j = 0; j < 4; ++j) { hw[j].x = pk2(v[j].x, v[j].y); hw[j].y = pk2(v[j].z, v[j].w); *((v2u*)ob + lane + 64 * j) = hw[j]; }
        if (!ismem) {
            unsigned char* ol = ws + WS_XL + (size_t)row * DMODEL;
#pragma unroll
            for (int j = 0; j < 4; ++j) {
                const float r0 = (v[j].x - __builtin_bit_cast(float, hw[j].x << 16)) * 1024.0f, r1 = (v[j].y - __builtin_bit_cast(float, hw[j].x & 0xffff0000u)) * 1024.0f;
                const float r2 = (v[j].z - __builtin_bit_cast(float, hw[j].y << 16)) * 1024.0f, r3 = (v[j].w - __builtin_bit_cast(float, hw[j].y & 0xffff0000u)) * 1024.0f;
                unsigned w = __builtin_amdgcn_cvt_pk_fp8_f32(r0, r1, 0u, false); w = __builtin_amdgcn_cvt_pk_fp8_f32(r2, r3, w, true);
                *((unsigned*)ol + lane + 64 * j) = w; }
            if (lane < 16) ss[(size_t)row * 16 + lane] = (lane == 0) ? s : 0.f;
        } else if (lane == 0) ((float*)(ws + WS_MRSTD))[row] = rsqrtf(s * (1.0f / 1024.0f) + 1e-6f);
    }
    const int gt = blockIdx.x * (NWAVES * 64) + tid, NGT = G * NWAVES * 64;
    const int* pos = (const int*)A.in[2];
    for (int e = gt; e < MTOK * 32; e += NGT) {
        const int row = e >> 5, i = e & 31;
        const float inv_freq = 1.0f / powf(10000.0f, (float)(2 * i) / 64.0f);
        const float ang = (float)pos[row] * inv_freq;
        float sn, cs; sincosf(ang, &sn, &cs);
        ((float*)(ws + WS_COS))[e] = cs; ((float*)(ws + WS_SIN))[e] = sn;
    }
}

#define XB_TMO      128
#define XB_XCNT(j)  (256  + 64 * (j))
#define XB_XSUB(j)  (1280 + 64 * (j))
#define XB_XGEN(j)  (2304 + 64 * (j))
#define XB_TOP      3328
#define XB_TOPGEN   3392
#define XCD_BAR_WORDS 3456
#define XB_SPIN_CAP (1u << 18)

__device__ __forceinline__ unsigned xb_ld(unsigned* p)              { return __hip_atomic_load(p, __ATOMIC_RELAXED, __HIP_MEMORY_SCOPE_AGENT); }
__device__ __forceinline__ unsigned xb_add(unsigned* p, unsigned v) { return __hip_atomic_fetch_add(p, v, __ATOMIC_RELAXED, __HIP_MEMORY_SCOPE_AGENT); }
__device__ __forceinline__ unsigned xb_xcc_id() { return (unsigned)__builtin_amdgcn_s_getreg((3 << 11) | 20) & 0xFu; }
#define XB_SPIN(cond, bar) do { unsigned _sp = 0; while (cond) { __builtin_amdgcn_s_sleep(1); \
    if ((++_sp & 255u) == 0u) { if (xb_ld(&(bar)[XB_TMO])) break; if (_sp > XB_SPIN_CAP) { atomicAdd(&(bar)[XB_TMO], 1u); break; } } } } while (0)

struct XcdBarrier {
    unsigned* bar; unsigned x;
    volatile LAS unsigned* st;
};

__device__ __forceinline__ XcdBarrier xcd_barrier_post(unsigned* bar, volatile LAS unsigned* st) {
    XcdBarrier b; b.bar = bar; b.x = xb_xcc_id(); b.st = st;
    if (threadIdx.x == 0) (void)xb_add(&bar[XB_XCNT(b.x)], 1u);
    return b;
}
__device__ __forceinline__ void xcd_barrier_complete(unsigned* bar, unsigned x, unsigned& nloc, unsigned& nx) {
    const unsigned G = gridDim.x * gridDim.y * gridDim.z;
    unsigned sum, cnt, mine, sp = 0u;
    for (;;) {
        sum = 0u; cnt = 0u; mine = 0u;
#pragma unroll
        for (unsigned j = 0; j < 16; ++j) { const unsigned c = xb_ld(&bar[XB_XCNT(j)]); sum += c; cnt += (c > 0u) ? 1u : 0u; mine = (j == x) ? c : mine; }
        if (sum == G) break;
        __builtin_amdgcn_s_sleep(1);
        if ((++sp & 255u) == 0u) { if (xb_ld(&bar[XB_TMO])) break; if (sp > XB_SPIN_CAP) { atomicAdd(&bar[XB_TMO], 1u); break; } }
    }
    nloc = mine > 0u ? mine : 1u; nx = cnt > 0u ? cnt : 1u;
}

__device__ __forceinline__ void xcd_barrier(const XcdBarrier& b) {
    asm volatile("s_waitcnt vmcnt(0)" ::: "memory");
    __syncthreads();
    if (threadIdx.x == 0) {
        unsigned* bar = b.bar;
        __builtin_amdgcn_s_waitcnt(0);
        unsigned nloc = b.st[0], nx = b.st[1];
        if (nloc == 0u) { xcd_barrier_complete(bar, b.x, nloc, nx); b.st[0] = nloc; b.st[1] = nx; }
        const unsigned old = xb_add(&bar[XB_XSUB(b.x)], 1u);
        const unsigned gen = old / nloc;
        if (old + 1u == (gen + 1u) * nloc) {
            __builtin_amdgcn_fence(__ATOMIC_RELEASE, "agent");
            asm volatile("s_waitcnt vmcnt(0)" ::: "memory");
            const unsigned og = xb_add(&bar[XB_TOP], 1u);
            const unsigned tg = og / nx;
            if (og + 1u == (tg + 1u) * nx) xb_add(&bar[XB_TOPGEN], 1u);
            else XB_SPIN(xb_ld(&bar[XB_TOPGEN]) == tg, bar);
            __builtin_amdgcn_fence(__ATOMIC_ACQUIRE, "agent");
            xb_add(&bar[XB_XGEN(b.x)], 1u);
            asm volatile("s_waitcnt vmcnt(0)" ::: "memory");
        } else {
            XB_SPIN(xb_ld(&bar[XB_XGEN(b.x)]) == gen, bar);
            __builtin_amdgcn_fence(__ATOMIC_ACQUIRE, "agent");
            asm volatile("s_waitcnt vmcnt(0)" ::: "memory");
        }
    }
    __syncthreads();
}

constexpr size_t WS_BAR = 128 * 1024;
constexpr int LDS_BARW = 151552 - 64;

constexpr int NOPS = 4 + 7 * DEPTH;
constexpr size_t WS_TAB = 64 * 1024;
__device__ __forceinline__ void write_table(const KArgs& A) {
    unsigned char* ws = A.ws;
    pg8::OpDesc* tab = (pg8::OpDesc*)(ws + WS_TAB);
    float* ss = (float*)(ws + WS_SS);
    bf16* XB = (bf16*)(ws + WS_XB);
    bf16* HMID = (bf16*)(ws + WS_ACT);
    bf16 *Qs = (bf16*)(ws + WS_ACT + AO_Q), *Ks = (bf16*)(ws + WS_ACT + AO_K), *Vs = (bf16*)(ws + WS_ACT + AO_V), *Qm = (bf16*)(ws + WS_ACT + AO_QM), *Ocat = (bf16*)(ws + WS_ACT + AO_O);
    const float* cosT = (const float*)(ws + WS_COS); const float* sinT = (const float*)(ws + WS_SIN);
#pragma unroll 1
    for (int op = 0; op < NOPS; ++op) {
        pg8::OpDesc* d = tab + op;
#pragma unroll
        for (int i = 0; i < 10; ++i) d->p[i] = nullptr;
        d->f[0] = 0.f; d->f[1] = 0.f; d->i[0] = 0; d->i[1] = 0;
        if (op < 4) {
            const int L = op; const unsigned char* wl = ws + WS_W + (size_t)L * W_LAYER;
            d->type = 2; d->M = MROWS; d->N = 512; d->K = DMODEL; d->A = (const bf16*)(ws + WS_MEMB); d->Bt = (const bf16*)(wl + WO_MKV);
            d->p[0] = ws + WS_MRSTD; d->p[2] = ws + WS_MEMKV + (size_t)L * MiB; d->p[3] = ws + WS_MEMKV + (size_t)L * MiB + MiB / 2; d->p[6] = (const float*)A.in[12] + L * 64;
            d->i[0] = 2; d->i[1] = 128 + 8 * L;
        } else {
            const int L = (op - 4) / 7, k = (op - 4) % 7, j2 = L >> 1; const bool isb = (L & 1) != 0;
            const unsigned char* wl = ws + WS_W + (size_t)L * W_LAYER;
            if (k == 0 || k == 5) {
                d->type = 0; d->M = MTOK; d->N = 2 * DFF; d->K = DMODEL; d->A = XB; d->Bt = (const bf16*)(wl + (k == 0 ? WO_GU1 : WO_GU2));
                d->p[0] = HMID; d->p[1] = ss + (size_t)((3 * L + (k == 0 ? 0 : 2)) % 3) * MTOK * 16;
            } else if (k == 1 || k == 4 || k == 6) {
                d->type = 1; d->M = MTOK; d->N = DMODEL; d->K = (k == 4) ? DMODEL : DFF; d->A = (k == 4) ? Ocat : HMID;
                d->Bt = (const bf16*)(wl + ((k == 1) ? WO_D1 : (k == 4 ? WO_OUT : WO_D2)));
                const int nss = 3 * L + (k == 1 ? 1 : (k == 4 ? 2 : 3));
                d->p[0] = ws + WS_XL; d->p[1] = XB; d->p[2] = ss + (size_t)(nss % 3) * MTOK * 16; d->p[3] = A.out; d->f[0] = (k == 4) ? 1.0f : 0.5f; d->i[0] = (op == NOPS - 1) ? 1 : 0;
            } else if (k == 2) {
                d->type = 2; d->M = MTOK; d->N = INW; d->K = DMODEL; d->A = XB; d->Bt = (const bf16*)(wl + WO_IN);
                d->p[0] = ss + (size_t)((3 * L + 1) % 3) * MTOK * 16; d->p[1] = Qs; d->p[2] = Ks; d->p[3] = Vs; d->p[4] = Qm;
                d->p[5] = (isb ? (const float*)A.in[17] : (const float*)A.in[14]) + j2 * 64; d->p[6] = (isb ? (const float*)A.in[18] : (const float*)A.in[15]) + j2 * 64; d->p[7] = (const float*)A.in[11] + L * 64;
                d->p[8] = cosT; d->p[9] = sinT; d->i[0] = 1 | (isb ? 4 : 0);
            } else {
                d->type = 3; d->M = 0; d->N = 0; d->K = 0; d->A = nullptr; d->Bt = nullptr;
                d->p[0] = Qs; d->p[1] = Ks; d->p[2] = Vs; d->p[3] = Qm; d->p[4] = Ocat; d->p[5] = ws + WS_MEMKV + (size_t)L * MiB; d->p[6] = ws + WS_MEMKV + (size_t)L * MiB + MiB / 2;
                d->p[7] = (const float*)A.in[16] + (size_t)j2 * 12 * 257; d->p[8] = (const float*)A.in[23] + j2 * 128; d->p[9] = (unsigned*)(ws + WS_CTL) + 16 * L;
                d->i[0] = isb ? 1 : 0; d->f[1] = 1.f;
                if (isb) {
                    const float li = 0.8f - 0.6f * expf(-0.3f * (float)L);
                    const float *q1 = (const float*)A.in[19] + j2 * 64, *k1 = (const float*)A.in[20] + j2 * 64, *q2 = (const float*)A.in[21] + j2 * 64, *k2 = (const float*)A.in[22] + j2 * 64;
                    float s1 = 0.f, s2 = 0.f;
#pragma unroll 1
                    for (int i = 0; i < 64; ++i) { s1 += q1[i] * k1[i]; s2 += q2[i] * k2[i]; }
                    d->f[0] = expf(s1) - expf(s2) + li; d->f[1] = 1.0f - li;
                }
            }
        }
    }
}

__global__ void __launch_bounds__(NWAVES * 64, 2) mega_fwd(KArgs A) {
    extern __shared__ __attribute__((aligned(16))) unsigned char lds_raw[];
    cg::grid_group grid = cg::this_grid();
    LAS unsigned char* lds = (LAS unsigned char*)lds_raw;
    const int tid = threadIdx.x, lane = tid & 63, wave = __builtin_amdgcn_readfirstlane(tid >> 6);
    if (tid < 2) ((volatile LAS unsigned*)(lds + LDS_BARW))[tid] = 0u;
    __syncthreads();
    XcdBarrier xbar = xcd_barrier_post((unsigned*)(A.ws + WS_BAR), (volatile LAS unsigned*)(lds + LDS_BARW));
    if (A.op_lo < 0) {
#ifndef NO_TAB
        if (blockIdx.x == 0 && tid == 0) write_table(A);
#endif
#ifndef NO_PRO
        prologue(A, lds, tid, lane, wave);
#endif
        if (A.op_hi > 0) xcd_barrier(xbar);
        if (A.op_hi < -5) grid.sync();
    }
    const pg8::OpDesc* tab = (const pg8::OpDesc*)(A.ws + WS_TAB);
    const int op_lo = A.op_lo < 0 ? 0 : A.op_lo, op_hi = A.op_hi;
#pragma unroll 1
    for (int op = op_lo; op < op_hi; ++op) {
        const pg8::OpDesc* d = tab + op;
        const int type = __builtin_amdgcn_readfirstlane(d->type);
        if (type == 3) {
            att::Args a;
            a.Qs = (const ATT_GAS bf16*)d->p[0]; a.Ks = (const ATT_GAS bf16*)d->p[1]; a.Vs = (const ATT_GAS bf16*)d->p[2]; a.Qm = (const ATT_GAS bf16*)d->p[3]; a.Ocat = (ATT_GAS bf16*)d->p[4];
            a.memK = (const ATT_GAS bf16*)d->p[5]; a.memV = (const ATT_GAS bf16*)d->p[6]; a.relb = (const ATT_GAS float*)d->p[7]; a.subln = (const ATT_GAS float*)d->p[8];
            a.lam = d->f[0]; a.one_m_li = d->f[1];
#ifndef NO_ATT
            att::attn_phase((__attribute__((address_space(3))) char*)lds, a, d->i[0], (ATT_GAS unsigned*)d->p[9]);
#if PROBE_ATT2
            xcd_barrier(xbar);
            att::attn_phase((__attribute__((address_space(3))) char*)lds, a, d->i[0], (ATT_GAS unsigned*)d->p[9] + 8);
#endif
#endif
        } else {
            const int G = gridDim.x, bx = blockIdx.x;
            pg8::Gemm g{(const pg8::bf16_t*)(const ATT_GAS pg8::bf16_t*)d->A, (const pg8::bf16_t*)(const ATT_GAS pg8::bf16_t*)d->Bt, d->M, d->N, d->K};
            pg8::StaticOrder S; S.init(d->M, d->N, G, (((bx - d->i[1]) % G) + G) % G);
#if PROBE_GEMM2
            for (int rep = ((PROBE_GEMM2 >> type) & 1) ? 0 : 1; rep < 2; ++rep) {
            if (rep == 1 && ((PROBE_GEMM2 >> type) & 1)) xcd_barrier(xbar);
#endif
#ifndef NO_GU
            if (type == 0) { pg8::EpiGateUp E{d}; pg8::gemm_phase<pg8::EpiGateUp, pg8::StaticOrder, true, true>(lds, g, S, E); }
#endif
#ifndef NO_RES
#if PROBE_GEMM2
            const float smul = (rep == 0) ? 0.f : 1.f;
#else
            const float smul = 1.f;
#endif
            if (type == 1) { pg8::EpiResid E{d, smul}; pg8::gemm_phase<pg8::EpiResid, pg8::StaticOrder, true, true>(lds, g, S, E); }
#endif
#ifndef NO_PROJ
            if (type == 2) { pg8::EpiProj E{d}; pg8::gemm_phase<pg8::EpiProj, pg8::StaticOrder, true, true>(lds, g, S, E); }
#endif
#if PROBE_GEMM2
            }
#endif
        }
        if (op >= 4 && op + 1 < op_hi) xcd_barrier(xbar);
#if PROBE_SYNC2
        if (op >= 4 && op + 1 < op_hi) { xcd_barrier(xbar); xcd_barrier(xbar); xcd_barrier(xbar); xcd_barrier(xbar); }
#endif
    }
}

extern "C" void kernel_launch(void* const* d_in, const int* in_sizes, int n_in, void* d_out, int out_size, void* d_ws, size_t ws_size, hipStream_t stream) {
    static int grid = 0;
    if (grid == 0) {
        if (n_in != 28 || out_size != MTOK * DMODEL || ws_size < WS_END) { fprintf(stderr, "kernel_launch: unexpected problem (n_in %d, out %d, ws %zu < %zu)\n", n_in, out_size, ws_size, (size_t)WS_END); grid = -1; return; }
        int dev = 0, cus = 0, per_cu = 0;
        hipGetDevice(&dev); hipDeviceGetAttribute(&cus, hipDeviceAttributeMultiprocessorCount, dev);
        if (hipFuncSetAttribute((const void*)mega_fwd, hipFuncAttributeMaxDynamicSharedMemorySize, LDS_BYTES) != hipSuccess) { fprintf(stderr, "kernel_launch: hipFuncSetAttribute failed\n"); grid = -1; return; }
        if (hipOccupancyMaxActiveBlocksPerMultiprocessor(&per_cu, (const void*)mega_fwd, NWAVES * 64, LDS_BYTES) != hipSuccess || per_cu < 1) { fprintf(stderr, "kernel_launch: occupancy query gives %d\n", per_cu); per_cu = 1; }
        (void)hipGetLastError();
        grid = cus * per_cu;
        fprintf(stderr, "kernel_launch: grid %d (cus %d x %d)\n", grid, cus, per_cu);
    }
    if (grid < 0) return;
    if (hipMemsetAsync((char*)d_ws + WS_CTL, 0, 256 * 1024, stream) != hipSuccess) { fprintf(stderr, "kernel_launch: memset failed\n"); return; }
    KArgs a{};
    for (int i = 0; i < 28; ++i) a.in[i] = d_in[i];
    a.out = (float*)d_out; a.ws = (unsigned char*)d_ws; a.op_lo = -1; a.op_hi = NOPS;
    void* params[] = {&a};
    hipError_t e = hipLaunchCooperativeKernel((const void*)mega_fwd, dim3(grid), dim3(NWAVES * 64), params, LDS_BYTES, stream);
    if (e != hipSuccess) fprintf(stderr, "kernel_launch: cooperative launch failed: %s (grid %d)\n", hipGetErrorString(e), grid);
}
```

```cpp
#include <hip/hip_runtime.h>
#include <hip/hip_cooperative_groups.h>
#include <cstdio>
#include <cstdint>
namespace cg = cooperative_groups;

namespace pg8 {
#define PG8_LAS __attribute__((address_space(3)))
typedef unsigned short bf16_t;
typedef short bf16x8 __attribute__((ext_vector_type(8)));
typedef float f32x4 __attribute__((ext_vector_type(4)));
typedef unsigned u32x4 __attribute__((ext_vector_type(4)));
constexpr int BM = 256, BK = 64, HALF = 128, HTB = HALF * BK * 2  , STAGE_BYTES = 8 * HTB, NXCD = 8, WGM = 8;

__host__ __device__ __forceinline__ int lds_byte(int r, int c) { const int st = (r >> 4) * 2 + (c >> 5), rr = r & 15, cc = c & 31, ob = rr * 64 + cc * 2; return st * 1024 + (ob ^ (((ob >> 9) & 1) << 5)); }
__host__ __device__ __forceinline__ void stage_rc(int b, int& R, int& C) { const int st = b / 1024, sb = b % 1024, swz = sb ^ (((sb >> 9) & 1) << 5); R = (st >> 1) * 16 + swz / 64; C = (st & 1) * 32 + (swz % 64) / 2; }
__host__ __device__ __forceinline__ int perm32(int rho) { const int n = rho >> 4, i = rho & 15; return 8 * (i >> 2) + 4 * n + (i & 3); }

struct Unit { int pm, pn; };
struct Gemm { const bf16_t* A; const bf16_t* Bt; int M, N, K; };

struct StaticOrder {
    int nM, nN, nwg, G, c;
    __host__ __device__ void init(int M, int N, int G_, int c_) { nM = M / BM; nN = N / BM; nwg = nM * nN; G = G_; c = c_; }
    __host__ __device__ bool next(int i, Unit& u) const {
        const long L = (long)i * G + c; if (L >= nwg) return false;
        int wgid = (int)L; { const int q = nwg / NXCD, r = nwg % NXCD, xcd = wgid % NXCD, off = wgid / NXCD; wgid = (xcd < r ? xcd * (q + 1) : r * (q + 1) + (xcd - r) * q) + off; }
        const int nig = WGM * nN, gid = wgid / nig, fm = gid * WGM, gsz = (nM - fm) < WGM ? (nM - fm) : WGM;
        u.pm = fm + ((wgid % nig) % gsz); u.pn = (wgid % nig) / gsz; return true;
    }
    __device__ __forceinline__ void a_ready(const Unit&) const {}
    __device__ __forceinline__ void done(const Unit&) const {}
};


__device__ __forceinline__ unsigned cvt_pk_bf16(float lo, float hi) { unsigned r; asm volatile("v_cvt_pk_bf16_f32 %0, %1, %2" : "=v"(r) : "v"(lo), "v"(hi)); return r; }
typedef float f32x2 __attribute__((ext_vector_type(2)));


#define PG8_GAS __attribute__((address_space(1)))
constexpr float RMS_EPS = 1e-6f;
constexpr float QK_C2 = 0.125f * 1.4426950408889634f;
__device__ __forceinline__ float fast_silu(float g) { return g * __builtin_amdgcn_rcpf(1.0f + __builtin_amdgcn_exp2f(-1.4426950408889634f * g)); }


struct OpDesc {
    int type, M, N, K;
    const bf16_t* A; const bf16_t* Bt;
    const void* p[10];
    float f[2]; int i[2];
};
static_assert(sizeof(OpDesc) == 128, "OpDesc");

__device__ __forceinline__ void row_rstd8(const PG8_GAS float* ssp, int row0, int fq, float (&rstd)[8]) {
    f32x4 t[8];
#pragma unroll
    for (int i = 0; i < 8; ++i) t[i] = *(const PG8_GAS f32x4*)(ssp + (size_t)(row0 + (i >> 2) * HALF + (i & 3) * 16) * 16 + 4 * fq);
#pragma unroll
    for (int i = 0; i < 8; ++i) { float s = (t[i][0] + t[i][1]) + (t[i][2] + t[i][3]); s += __shfl_xor(s, 16); s += __shfl_xor(s, 32); rstd[i] = rsqrtf(s * (1.0f / 1024.0f) + RMS_EPS); }
}

__device__ __forceinline__ void row_ms8(const PG8_GAS float* ssp, int row0, int fq, float (&ms)[8]) {
    f32x4 t[8];
#pragma unroll
    for (int i = 0; i < 8; ++i) t[i] = *(const PG8_GAS f32x4*)(ssp + (size_t)(row0 + (i >> 2) * HALF + (i & 3) * 16) * 16 + 4 * fq);
#pragma unroll
    for (int i = 0; i < 8; ++i) { float s = (t[i][0] + t[i][1]) + (t[i][2] + t[i][3]); s += __shfl_xor(s, 16); s += __shfl_xor(s, 32); ms[i] = s * (1.0f / 1024.0f) + RMS_EPS; }
}

struct EpiCtx { int ui; PG8_LAS unsigned char* lds; int tid; };
constexpr int STAT_OFF = STAGE_BYTES + 1024;

struct EpiGateUp {
    static constexpr bool PERM = true, AFTER_DRAIN = false;
    const OpDesc* d;
    __device__ __forceinline__ void operator()(const f32x4 (&acc)[2][2][4][2], const Unit& u, int wr, int wc, int fr, int fq, const EpiCtx& c) const {
        PG8_GAS bf16_t* H = (PG8_GAS bf16_t*)d->p[0]; const PG8_GAS float* ss = (const PG8_GAS float*)d->p[1]; const int ldh = 2816;
        const int row0 = u.pm * BM + wr * 64 + fr, col0 = u.pn * HALF + wc * 32 + 8 * fq;
        float ms8[8];
        PG8_LAS float* slot = (PG8_LAS float*)(c.lds + STAT_OFF) + c.tid;
        PG8_LAS int* pmslot = (PG8_LAS int*)(slot + 8 * 512);
        if (c.ui == 0 || pmslot[0] != u.pm) { row_ms8(ss, row0, fq, ms8); pmslot[0] = u.pm;
#pragma unroll
            for (int i = 0; i < 8; ++i) slot[i * 512] = ms8[i]; }
        else {
#pragma unroll
            for (int i = 0; i < 8; ++i) ms8[i] = slot[i * 512];
        }
#pragma unroll
        for (int ai = 0; ai < 2; ++ai)
#pragma unroll
            for (int m = 0; m < 4; ++m) {
                const int row = row0 + ai * HALF + m * 16;
                const float ms = ms8[ai * 4 + m], c = -1.4426950408889634f * rsqrtf(ms);
                float hv[8];
#pragma unroll
                for (int n = 0; n < 2; ++n)
#pragma unroll
                    for (int jp = 0; jp < 2; ++jp) {
                        const f32x2 g = (f32x2){acc[ai][0][m][n][2 * jp], acc[ai][0][m][n][2 * jp + 1]}, uu = (f32x2){acc[ai][1][m][n][2 * jp], acc[ai][1][m][n][2 * jp + 1]};
                        const f32x2 t = g * c; f32x2 ee; ee.x = __builtin_amdgcn_exp2f(t.x); ee.y = __builtin_amdgcn_exp2f(t.y);
                        const f32x2 dd = ee * ms + ms; f32x2 sg; sg.x = __builtin_amdgcn_rcpf(dd.x); sg.y = __builtin_amdgcn_rcpf(dd.y);
                        const f32x2 h = (g * uu) * sg;
                        hv[4 * n + 2 * jp] = h.x; hv[4 * n + 2 * jp + 1] = h.y; }
                u32x4 w; w.x = cvt_pk_bf16(hv[0], hv[1]); w.y = cvt_pk_bf16(hv[2], hv[3]); w.z = cvt_pk_bf16(hv[4], hv[5]); w.w = cvt_pk_bf16(hv[6], hv[7]);
                *(PG8_GAS u32x4*)(H + (size_t)row * ldh + col0) = w;
            }
    }
};

__device__ __forceinline__ float bf_lo(unsigned w) { return __builtin_bit_cast(float, w << 16); }
__device__ __forceinline__ float bf_hi(unsigned w) { return __builtin_bit_cast(float, w & 0xffff0000u); }
typedef unsigned u32x2 __attribute__((ext_vector_type(2)));
struct EpiResid {
    static constexpr bool PERM = true, AFTER_DRAIN = false;
    const OpDesc* d; float smul;
    __device__ __forceinline__ void operator()(const f32x4 (&acc)[2][2][4][2], const Unit& u, int wr, int wc, int fr, int fq, const EpiCtx&) const {
        PG8_GAS unsigned char* XL = (PG8_GAS unsigned char*)d->p[0]; PG8_GAS bf16_t* XB = (PG8_GAS bf16_t*)d->p[1]; PG8_GAS float* ssn = (PG8_GAS float*)d->p[2]; PG8_GAS float* OUT = (PG8_GAS float*)d->p[3];
        const float scale = d->f[0] * smul; const bool last = d->i[0] != 0;
        const int row0 = u.pm * BM + wr * 64 + fr, col0 = u.pn * BM + wc * 32 + 8 * fq;
        u32x4 hv[3][2]; u32x2 lv[3][2];
#define RES_LOAD(set, k_) do { const size_t o_ = (size_t)(row0 + ((k_) >> 2) * HALF + ((k_) & 3) * 16) * 1024 + col0; \
            _Pragma("unroll") for (int bj = 0; bj < 2; ++bj) { hv[set][bj] = *(const PG8_GAS u32x4*)(XB + o_ + bj * HALF); lv[set][bj] = *(const PG8_GAS u32x2*)(XL + o_ + bj * HALF); } } while (0)
        RES_LOAD(0, 0); RES_LOAD(1, 1);
#pragma unroll
        for (int k = 0; k < 8; ++k) {
            const int ai = k >> 2, m = k & 3, cur = k % 3;
            if (k + 2 < 8) RES_LOAD((k + 2) % 3, k + 2);
            const int row = row0 + ai * HALF + m * 16;
            const size_t o_ = (size_t)row * 1024 + col0;
            float sq = 0.f;
#pragma unroll
            for (int bj = 0; bj < 2; ++bj) {
                float x[8];
                const f32x2 l01 = __builtin_amdgcn_cvt_pk_f32_fp8(lv[cur][bj][0], false), l23 = __builtin_amdgcn_cvt_pk_f32_fp8(lv[cur][bj][0], true);
                const f32x2 l45 = __builtin_amdgcn_cvt_pk_f32_fp8(lv[cur][bj][1], false), l67 = __builtin_amdgcn_cvt_pk_f32_fp8(lv[cur][bj][1], true);
                const float lo8[8] = {l01[0], l01[1], l23[0], l23[1], l45[0], l45[1], l67[0], l67[1]};
#pragma unroll
                for (int q = 0; q < 4; ++q) {
                    x[2 * q] = (bf_lo(hv[cur][bj][q]) + lo8[2 * q] * (1.0f / 1024.0f)) + acc[ai][bj][m][q >> 1][(2 * q) & 3] * scale;
                    x[2 * q + 1] = (bf_hi(hv[cur][bj][q]) + lo8[2 * q + 1] * (1.0f / 1024.0f)) + acc[ai][bj][m][q >> 1][(2 * q + 1) & 3] * scale;
                }
#pragma unroll
                for (int q = 0; q < 8; ++q) sq += x[q] * x[q];
                if (last) {
                    *(PG8_GAS f32x4*)(OUT + o_ + bj * HALF) = (f32x4){x[0], x[1], x[2], x[3]}; *(PG8_GAS f32x4*)(OUT + o_ + bj * HALF + 4) = (f32x4){x[4], x[5], x[6], x[7]};
                } else {
                    u32x4 h; u32x2 l; float rr[8];
#pragma unroll
                    for (int q = 0; q < 4; ++q) { const unsigned hw = cvt_pk_bf16(x[2 * q], x[2 * q + 1]); h[q] = hw; rr[2 * q] = __builtin_amdgcn_fmed3f((x[2 * q] - bf_lo(hw)) * 1024.0f, -448.0f, 448.0f); rr[2 * q + 1] = __builtin_amdgcn_fmed3f((x[2 * q + 1] - bf_hi(hw)) * 1024.0f, -448.0f, 448.0f); }
                    l[0] = __builtin_amdgcn_cvt_pk_fp8_f32(rr[0], rr[1], 0u, false); l[0] = __builtin_amdgcn_cvt_pk_fp8_f32(rr[2], rr[3], l[0], true);
                    l[1] = __builtin_amdgcn_cvt_pk_fp8_f32(rr[4], rr[5], 0u, false); l[1] = __builtin_amdgcn_cvt_pk_fp8_f32(rr[6], rr[7], l[1], true);
                    *(PG8_GAS u32x4*)(XB + o_ + bj * HALF) = h; *(PG8_GAS u32x2*)(XL + o_ + bj * HALF) = l;
                }
            }
            sq += __shfl_xor(sq, 16); sq += __shfl_xor(sq, 32);
            if (fq == 0) ssn[(size_t)row * 16 + u.pn * 4 + wc] = sq;
        }
#undef RES_LOAD
    }
};

struct EpiProj {
    static constexpr bool PERM = true, AFTER_DRAIN = false;
    const OpDesc* d;
    __device__ __forceinline__ void operator()(const f32x4 (&acc)[2][2][4][2], const Unit& u, int wr, int wc, int fr, int fq, const EpiCtx& c) const {
        const int fl = d->i[0]; const int stat_is_ss = fl & 1, memmode = (fl >> 1) & 1, rope = (fl >> 2) & 1;
        int kind, tcol, ld;
        if (memmode) { kind = (u.pn == 0) ? 1 : 2; tcol = 0; ld = 256; }
        else { kind = u.pn < 3 ? 0 : (u.pn < 6 ? 1 : (u.pn < 9 ? 2 : 3)); tcol = (u.pn - 3 * kind) * 256; ld = (kind == 3) ? 256 : 768; }
        PG8_GAS bf16_t* out = (PG8_GAS bf16_t*)d->p[1 + kind];
        const PG8_GAS float* gp = (kind == 2) ? nullptr : (const PG8_GAS float*)d->p[kind == 3 ? 7 : 5 + kind];
        const PG8_GAS float* rowstat = (const PG8_GAS float*)d->p[0]; const PG8_GAS float* cosT = (const PG8_GAS float*)d->p[8]; const PG8_GAS float* sinT = (const PG8_GAS float*)d->p[9];
        const float sc = (kind == 0 || kind == 3) ? QK_C2 : 1.0f;
        const bool dorope = rope && kind < 2 && !memmode;
        f32x4 gv[2][2];
#pragma unroll
        for (int bj = 0; bj < 2; ++bj)
#pragma unroll
            for (int n = 0; n < 2; ++n) gv[bj][n] = gp ? *(const PG8_GAS f32x4*)(gp + 32 * bj + 8 * fq + 4 * n) : (f32x4){1.f, 1.f, 1.f, 1.f};
        const int row0 = u.pm * BM + wr * 64 + fr;
        float rstd8[8];
        PG8_LAS float* slot = (PG8_LAS float*)(c.lds + STAT_OFF) + c.tid;
        PG8_LAS int* pmslot = (PG8_LAS int*)(slot + 8 * 512);
        if (stat_is_ss && c.ui != 0 && pmslot[0] == u.pm) {
#pragma unroll
            for (int i = 0; i < 8; ++i) rstd8[i] = slot[i * 512];
        } else if (stat_is_ss) { row_rstd8(rowstat, row0, fq, rstd8); pmslot[0] = u.pm;
#pragma unroll
            for (int i = 0; i < 8; ++i) slot[i * 512] = rstd8[i]; }
        else {
#pragma unroll
            for (int i = 0; i < 8; ++i) rstd8[i] = rowstat[row0 + (i >> 2) * HALF + (i & 3) * 16];
        }
#pragma unroll
        for (int am = 0; am < 4; ++am) {
            const int ai = am >> 1;
            f32x4 cv[2][2], sv[2][2];
            if (dorope) {
#pragma unroll
                for (int m2 = 0; m2 < 2; ++m2)
#pragma unroll
                    for (int n = 0; n < 2; ++n) { const size_t o_ = (size_t)(row0 + ai * HALF + ((am & 1) * 2 + m2) * 16) * 32 + 8 * fq + 4 * n; cv[m2][n] = *(const PG8_GAS f32x4*)(cosT + o_); sv[m2][n] = *(const PG8_GAS f32x4*)(sinT + o_); }
            }
#pragma unroll
            for (int m2 = 0; m2 < 2; ++m2) {
                const int m = (am & 1) * 2 + m2;
                const int row = row0 + ai * HALF + m * 16;
                const float rs = rstd8[ai * 4 + m];
                f32x4 v[2][2];
#pragma unroll
                for (int bj = 0; bj < 2; ++bj)
#pragma unroll
                    for (int n = 0; n < 2; ++n) v[bj][n] = acc[ai][bj][m][n] * rs;
                if (gp) {
                    float sq = 0.f;
#pragma unroll
                    for (int bj = 0; bj < 2; ++bj)
#pragma unroll
                        for (int n = 0; n < 2; ++n) sq += (v[bj][n][0] * v[bj][n][0] + v[bj][n][1] * v[bj][n][1]) + (v[bj][n][2] * v[bj][n][2] + v[bj][n][3] * v[bj][n][3]);
                    sq += __shfl_xor(sq, 16); sq += __shfl_xor(sq, 32);
                    const float hr = rsqrtf(sq * (1.0f / 64.0f) + RMS_EPS);
#pragma unroll
                    for (int bj = 0; bj < 2; ++bj)
#pragma unroll
                        for (int n = 0; n < 2; ++n) v[bj][n] = v[bj][n] * hr * gv[bj][n];
                    if (dorope) {
#pragma unroll
                        for (int n = 0; n < 2; ++n) {
                            const f32x4 c = cv[m2][n], s = sv[m2][n];
                            const f32x4 x1 = v[0][n], x2 = v[1][n];
                            v[0][n] = x1 * c - x2 * s; v[1][n] = x2 * c + x1 * s;
                        }
                    }
#pragma unroll
                    for (int bj = 0; bj < 2; ++bj)
#pragma unroll
                        for (int n = 0; n < 2; ++n) v[bj][n] = v[bj][n] * sc;
                }
                PG8_GAS bf16_t* op = out + (size_t)row * ld + tcol + 64 * wc + 8 * fq;
#pragma unroll
                for (int bj = 0; bj < 2; ++bj) {
                    u32x4 w; w.x = cvt_pk_bf16(v[bj][0][0], v[bj][0][1]); w.y = cvt_pk_bf16(v[bj][0][2], v[bj][0][3]); w.z = cvt_pk_bf16(v[bj][1][0], v[bj][1][1]); w.w = cvt_pk_bf16(v[bj][1][2], v[bj][1][3]);
                    *(PG8_GAS u32x4*)(op + 32 * bj) = w;
                }
            }
        }
    }
};

template <class Epi, class Sched, bool ALIGN_EPI = false, bool SP2 = false>
__device__ __forceinline__ void gemm_phase(PG8_LAS unsigned char* lds, const Gemm g, const Sched& S, const Epi& E) {
    int tid_ = threadIdx.x; asm volatile("" : "+v"(tid_));
    const int tid = tid_, wid = __builtin_amdgcn_readfirstlane(tid >> 6), lane = tid & 63, wr = wid >> 2, wc = wid & 3, fr = lane & 15, fq = lane >> 4;
    const int K = g.K, nt = K / BK;
    unsigned voffA[2], voffB[2];
#pragma unroll
    for (int i = 0; i < 2; ++i) { int R, C; stage_rc(tid * 16 + i * 8192, R, C); const int Rb = Epi::PERM ? ((R & ~31) + perm32(R & 31)) : R;
        voffA[i] = (unsigned)(R * K + C) * 2u; voffB[i] = (unsigned)(Rb * K + C) * 2u; }
    const size_t kstep = (size_t)(BK * 2);
    const size_t hstep = (size_t)HALF * K * 2;
    const size_t tstep = 2 * hstep;
    const unsigned ldsw = (unsigned)wid * 1024u;
    const int aoff = lds_byte(wr * 64 + fr, fq * 8), boff = lds_byte(wc * 32 + fr, fq * 8);
#define PG8_SA(b, h) (((b) * 2 + (h)) * HTB)
#define PG8_SB(b, h) ((4 + (b) * 2 + (h)) * HTB)
#define PG8_STAGE(bufoff, gbase, voff) do { _Pragma("unroll") for (int _i = 0; _i < 2; ++_i) \
        __builtin_amdgcn_global_load_lds((const unsigned*)((const char*)(gbase) + (voff)[_i]), (PG8_LAS unsigned*)(lds + (bufoff) + ldsw + _i * 8192), 16, 0, 0); } while (0)
#define PG8_LDA(dst, b, h) do { _Pragma("unroll") for (int m = 0; m < 4; ++m) _Pragma("unroll") for (int k = 0; k < 2; ++k) dst[m][k] = *(const PG8_LAS bf16x8*)(lds + PG8_SA(b, h) + aoff + m * 2048 + k * 1024); } while (0)
#define PG8_LDB(dst, b, h) do { _Pragma("unroll") for (int n = 0; n < 2; ++n) _Pragma("unroll") for (int k = 0; k < 2; ++k) dst[n][k] = *(const PG8_LAS bf16x8*)(lds + PG8_SB(b, h) + boff + n * 2048 + k * 1024); } while (0)
#define PG8_MMA(ai, bj, At, Bt) do { __builtin_amdgcn_s_setprio(1); _Pragma("unroll") for (int m = 0; m < 4; ++m) _Pragma("unroll") for (int n = 0; n < 2; ++n) _Pragma("unroll") for (int k = 0; k < 2; ++k) \
        acc[ai][bj][m][n] = __builtin_amdgcn_mfma_f32_16x16x32_bf16(Bt[n][k], At[m][k], acc[ai][bj][m][n], 0, 0, 0); __builtin_amdgcn_s_setprio(0); } while (0)
#define PG8_WAIT_V(n) asm volatile("s_waitcnt vmcnt(" #n ")" ::: "memory")
#define PG8_WAIT_L(n) asm volatile("s_waitcnt lgkmcnt(" #n ")" ::: "memory")
#define PG8_BAR __builtin_amdgcn_s_barrier()
#define PG8_SCHED __builtin_amdgcn_sched_barrier(0)
    Unit cur, nxt; int ui = 0;
    if (!S.next(0, cur)) return;
    f32x4 acc[2][2][4][2];
#pragma unroll
    for (int a = 0; a < 2; ++a)
#pragma unroll
        for (int b = 0; b < 2; ++b)
#pragma unroll
            for (int m = 0; m < 4; ++m)
#pragma unroll
                for (int n = 0; n < 2; ++n) acc[a][b][m][n] = (f32x4){0.f, 0.f, 0.f, 0.f};
    bf16x8 At[4][2], B0[2][2], B1[2][2];
    const char* cA = (const char*)g.A + (size_t)cur.pm * tstep; const char* cB = (const char*)g.Bt + (size_t)cur.pn * tstep;
    S.a_ready(cur);
    if constexpr (SP2) {
        PG8_STAGE(PG8_SB(0, 0), cB, voffB); PG8_STAGE(PG8_SB(0, 1), cB + hstep, voffB); PG8_STAGE(PG8_SA(0, 0), cA, voffA); PG8_STAGE(PG8_SA(0, 1), cA + hstep, voffA);
        if (wr == 1) PG8_BAR;
        PG8_WAIT_V(2); PG8_BAR;
        PG8_STAGE(PG8_SB(1, 0), cB + kstep, voffB); PG8_STAGE(PG8_SA(1, 0), cA + kstep, voffA); PG8_STAGE(PG8_SB(1, 1), cB + hstep + kstep, voffB);
        PG8_WAIT_V(6); PG8_BAR;
    } else {
        PG8_STAGE(PG8_SB(0, 0), cB, voffB); PG8_STAGE(PG8_SA(0, 0), cA, voffA); PG8_STAGE(PG8_SB(0, 1), cB + hstep, voffB); PG8_STAGE(PG8_SA(0, 1), cA + hstep, voffA);
        if (wr == 1) PG8_BAR;
        PG8_WAIT_V(4); PG8_BAR;
        PG8_STAGE(PG8_SB(1, 0), cB + kstep, voffB); PG8_STAGE(PG8_SA(1, 0), cA + kstep, voffA); PG8_STAGE(PG8_SB(1, 1), cB + hstep + kstep, voffB);
        PG8_WAIT_V(6); PG8_BAR;
    }
    for (;;) {
        const bool has_next = S.next(ui + 1, nxt);
        const char* nA = has_next ? (const char*)g.A + (size_t)nxt.pm * tstep : cA; const char* nB = has_next ? (const char*)g.Bt + (size_t)nxt.pn * tstep : cB;
        for (int t = 0; t < nt; t += 2) {
            const bool last = (t == nt - 2);
            const char* a1 = cA + (size_t)(t + 1) * kstep;
            const char* a2 = last ? nA : cA + (size_t)(t + 2) * kstep; const char* b2 = last ? nB : cB + (size_t)(t + 2) * kstep;
            const char* a3 = a2 + kstep; const char* b3 = b2 + kstep;
            if (last && has_next) S.a_ready(nxt);
            if constexpr (SP2) {
            PG8_LDB(B0, 0, 0); PG8_LDB(B1, 0, 1); PG8_SCHED; PG8_LDA(At, 0, 0); PG8_STAGE(PG8_SA(1, 1), a1 + hstep, voffA);
            PG8_WAIT_V(8); PG8_WAIT_L(0); PG8_BAR; PG8_MMA(0, 0, At, B0); PG8_MMA(0, 1, At, B1); PG8_BAR; PG8_SCHED;
            PG8_LDA(At, 0, 1); PG8_STAGE(PG8_SB(0, 0), b2, voffB); PG8_STAGE(PG8_SB(0, 1), b2 + hstep, voffB); PG8_STAGE(PG8_SA(0, 0), a2, voffA);
            PG8_WAIT_V(8); PG8_WAIT_L(0); PG8_BAR; PG8_MMA(1, 0, At, B0); PG8_MMA(1, 1, At, B1); PG8_BAR; PG8_SCHED;
            PG8_LDB(B0, 1, 0); PG8_LDB(B1, 1, 1); PG8_SCHED; PG8_LDA(At, 1, 0); PG8_STAGE(PG8_SA(0, 1), a2 + hstep, voffA);
            PG8_WAIT_V(8); PG8_WAIT_L(0); PG8_BAR; PG8_MMA(0, 0, At, B0); PG8_MMA(0, 1, At, B1); PG8_BAR; PG8_SCHED;
            PG8_LDA(At, 1, 1); PG8_STAGE(PG8_SB(1, 0), b3, voffB); PG8_STAGE(PG8_SB(1, 1), b3 + hstep, voffB); PG8_STAGE(PG8_SA(1, 0), a3, voffA);
            PG8_WAIT_V(8); PG8_WAIT_L(0); PG8_BAR; PG8_MMA(1, 0, At, B0); PG8_MMA(1, 1, At, B1); PG8_BAR; PG8_SCHED;
            } else {
            PG8_LDB(B0, 0, 0); PG8_SCHED; PG8_LDA(At, 0, 0); PG8_STAGE(PG8_SA(1, 1), a1 + hstep, voffA);
            PG8_WAIT_L(8); PG8_BAR; PG8_WAIT_L(0); PG8_MMA(0, 0, At, B0); PG8_BAR; PG8_SCHED;
            PG8_LDB(B1, 0, 1); PG8_STAGE(PG8_SB(0, 0), b2, voffB);
            PG8_BAR; PG8_WAIT_L(0); PG8_MMA(0, 1, At, B1); PG8_BAR;
            PG8_LDA(At, 0, 1); PG8_STAGE(PG8_SA(0, 0), a2, voffA);
            PG8_BAR; PG8_WAIT_L(0); PG8_MMA(1, 0, At, B0); PG8_BAR; PG8_SCHED;
            PG8_STAGE(PG8_SB(0, 1), b2 + hstep, voffB);
            PG8_WAIT_V(6); PG8_BAR; PG8_MMA(1, 1, At, B1); PG8_BAR;
            PG8_LDB(B0, 1, 0); PG8_SCHED; PG8_LDA(At, 1, 0); PG8_STAGE(PG8_SA(0, 1), a2 + hstep, voffA);
            PG8_WAIT_L(8); PG8_BAR; PG8_WAIT_L(0); PG8_MMA(0, 0, At, B0); PG8_BAR; PG8_SCHED;
            PG8_LDB(B1, 1, 1); PG8_STAGE(PG8_SB(1, 0), b3, voffB);
            PG8_BAR; PG8_WAIT_L(0); PG8_MMA(0, 1, At, B1); PG8_BAR;
            PG8_LDA(At, 1, 1); PG8_STAGE(PG8_SA(1, 0), a3, voffA);
            PG8_BAR; PG8_WAIT_L(0); PG8_MMA(1, 0, At, B0); PG8_BAR; PG8_SCHED;
            PG8_STAGE(PG8_SB(1, 1), b3 + hstep, voffB);
            PG8_WAIT_V(6); PG8_BAR; PG8_MMA(1, 1, At, B1); PG8_BAR;
            }
        }
        if constexpr (ALIGN_EPI) { if (wr == 0) PG8_BAR; }
        if constexpr (!Epi::AFTER_DRAIN) { const EpiCtx ctx{ui, lds, tid}; E(acc, cur, wr, wc, fr, fq, ctx); S.done(cur); }
        if (!has_next) break;
#pragma unroll
        for (int a = 0; a < 2; ++a)
#pragma unroll
            for (int b = 0; b < 2; ++b)
#pragma unroll
                for (int m = 0; m < 4; ++m)
#pragma unroll
                    for (int n = 0; n < 2; ++n) acc[a][b][m][n] = (f32x4){0.f, 0.f, 0.f, 0.f};
        cur = nxt; cA = nA; cB = nB; ++ui;
        if constexpr (ALIGN_EPI) { if (wr == 1) PG8_BAR; }
    }
    PG8_WAIT_V(0);
    if constexpr (!ALIGN_EPI) { if (wr == 0) PG8_BAR; }
    PG8_BAR;
    if constexpr (Epi::AFTER_DRAIN) { E.fused(acc, cur, wr, wc, fr, fq, lds, wid, lane); S.done(cur); }
#undef PG8_SA
#undef PG8_SB
#undef PG8_STAGE
#undef PG8_LDA
#undef PG8_LDB
#undef PG8_MMA
#undef PG8_WAIT_V
#undef PG8_WAIT_L
#undef PG8_BAR
#undef PG8_SCHED
}
}


namespace att {
#define ATT_LAS __attribute__((address_space(3)))
#define ATT_GAS __attribute__((address_space(1)))
typedef unsigned short bf16_t;
typedef short bf16x8 __attribute__((ext_vector_type(8)));
typedef short s16x4 __attribute__((ext_vector_type(4)));
typedef float f32x16 __attribute__((ext_vector_type(16)));
typedef float f32x4 __attribute__((ext_vector_type(4)));
typedef unsigned u32x4 __attribute__((ext_vector_type(4)));
typedef unsigned u32x2 __attribute__((ext_vector_type(2)));
typedef float f32x2_t __attribute__((ext_vector_type(2))); typedef __bf16 bf16x2_t __attribute__((ext_vector_type(2)));
__device__ __forceinline__ unsigned cvtpk(float lo, float hi) { f32x2_t v = {lo, hi}; bf16x2_t b = __builtin_convertvector(v, bf16x2_t); return __builtin_bit_cast(unsigned, b); }
__device__ __forceinline__ s16x4 vtr(const ATT_LAS char* p) { return __builtin_bit_cast(s16x4, __builtin_amdgcn_ds_read_tr16_b64_v4i16((ATT_LAS s16x4*)p)); }
__device__ __forceinline__ float max3f(float x, float y, float z) { float r; asm("v_max3_f32 %0, %1, %2, %3" : "=v"(r) : "v"(x), "v"(y), "v"(z)); return r; }
__device__ __forceinline__ int crow(int r, int hi) { return (r & 3) + 8 * (r >> 2) + 4 * hi; }

constexpr int KSTR = 144, KSUB = 64 * KSTR, KBUF = 2 * KSUB;
constexpr int VBUF = 64 * 320;
constexpr int L_K = 0, L_V = 2 * KBUF, L_BIAS = L_V + 3 * VBUF, L_MISC = L_BIAS + 1056, L_Q = L_MISC + 64, L_END = L_Q + 8 * 4096;
constexpr float LOG2E = 1.4426950408889634f;
constexpr float RMS_EPS = 1e-6f;

struct Args {
    const ATT_GAS bf16_t *Qs, *Ks, *Vs, *Qm, *memK, *memV; ATT_GAS bf16_t* Ocat;
    const ATT_GAS float* relb;
    const ATT_GAS float* subln;
    float lam, one_m_li;
};

template <int KIND> __device__ __forceinline__ void attn_unit(ATT_LAS char* lds, const Args& a, int u) {
    constexpr int DV = (KIND == 1) ? 128 : 64, NDB = DV / 32, NC = (KIND == 1) ? 2 : 1, VSTR = (KIND == 1) ? 320 : 192;
    int tid_ = threadIdx.x; asm volatile("" : "+v"(tid_));
    const int tid = tid_, lane = tid & 63, r32 = lane & 31, hi = lane >> 5; const int wid = __builtin_amdgcn_readfirstlane(tid >> 6);
    int t_lo, t_hi, my_lo, my_hi, wchunk = 0, map = 0, qrow, ocol, kld, h;
    const ATT_GAS bf16_t *Qp, *Kp, *Vp;
    if (KIND == 0) {
        const int b = u / 192; h = (u >> 4) % 12; const int c0 = (u & 15) * 4;
        wchunk = c0 + (wid >> 1); qrow = b * 4096 + wchunk * 64 + (wid & 1) * 32;
        t_lo = c0 - 8 < 0 ? 0 : c0 - 8; t_hi = c0 + 3; my_lo = wchunk - 8 < 0 ? 0 : wchunk - 8; my_hi = wchunk;
        kld = 768; Qp = a.Qs + (size_t)qrow * 768 + h * 64; Kp = a.Ks + (size_t)b * 4096 * 768 + h * 64; Vp = a.Vs + (size_t)b * 4096 * 768 + h * 64; ocol = h * 64;
    } else if (KIND == 1) {
        const int qb = 31 - u / 24, bh = u % 24, b = bh / 6; h = bh % 6; const int c0 = 2 * qb, wq = wid & 3; map = wid >> 2;
        wchunk = c0 + (wq >> 1); qrow = b * 4096 + qb * 128 + wq * 32;
        t_lo = 0; t_hi = c0 + 1; my_lo = 0; my_hi = wchunk;
        kld = 768; Qp = a.Qs + (size_t)qrow * 768 + (h * 2 + map) * 64; Kp = a.Ks + (size_t)b * 4096 * 768 + h * 128; Vp = a.Vs + (size_t)b * 4096 * 768 + h * 128; ocol = h * 128;
    } else {
        const int b = u >> 6; h = (u >> 4) & 3; const int g = u & 15;
        qrow = b * 4096 + g * 256 + wid * 32; t_lo = 0; t_hi = 3; my_lo = 0; my_hi = 3;
        kld = 256; Qp = a.Qm + (size_t)qrow * 256 + h * 64; Kp = a.memK + (size_t)b * 256 * 256 + h * 64; Vp = a.memV + (size_t)b * 256 * 256 + h * 64; ocol = 768 + h * 64;
    }
    size_t ksrc[NC], vsrc[NC]; int kdst[NC], vdst[NC];
#pragma unroll
    for (int i = 0; i < NC; ++i) {
        if (KIND == 1) {
            ksrc[i] = (size_t)(tid >> 3) * 768 + i * 64 + (tid & 7) * 8; kdst[i] = i * KSUB + (tid >> 3) * KSTR + (tid & 7) * 16;
            const int key = (tid >> 4) + 32 * i; vsrc[i] = (size_t)key * 768 + (tid & 15) * 8; vdst[i] = key * VSTR + (tid & 15) * 16;
        } else {
            ksrc[i] = (size_t)(tid >> 3) * kld + (tid & 7) * 8; kdst[i] = (tid >> 3) * KSTR + (tid & 7) * 16;
            vsrc[i] = ksrc[i]; vdst[i] = (tid >> 3) * VSTR + (tid & 7) * 16;
        }
    }
    u32x4 kreg[NC], vreg[NC];
#define ATT_GLOAD(t) do { const size_t to_ = (size_t)(t) * 64 * kld; _Pragma("unroll") for (int i = 0; i < NC; ++i) { kreg[i] = *(const ATT_GAS u32x4*)(Kp + to_ + ksrc[i]); vreg[i] = *(const ATT_GAS u32x4*)(Vp + to_ + vsrc[i]); } } while (0)
#define ATT_LSTORE(kb_, vb_) do { _Pragma("unroll") for (int i = 0; i < NC; ++i) { *(ATT_LAS u32x4*)(lds + L_K + (kb_) * KBUF + kdst[i]) = kreg[i]; *(ATT_LAS u32x4*)(lds + L_V + (vb_) * VBUF + vdst[i]) = vreg[i]; } } while (0)
    constexpr int VSL = (KIND == 2) ? 64 * 192 : VBUF;
    u32x4 k4[4], v4[4];
    if (KIND == 2) {
#pragma unroll
        for (int tt = 0; tt < 4; ++tt) { k4[tt] = *(const ATT_GAS u32x4*)(Kp + (size_t)tt * 64 * kld + ksrc[0]); v4[tt] = *(const ATT_GAS u32x4*)(Vp + (size_t)tt * 64 * kld + vsrc[0]); }
    } else ATT_GLOAD(t_lo);
    ATT_LAS float* bt = (ATT_LAS float*)(lds + L_BIAS);
    if (KIND == 0) { if (tid < 257) bt[tid] = a.relb[h * 257 + tid] * LOG2E; }
    bf16x8 qr[4];
#pragma unroll
    for (int s = 0; s < 4; ++s) qr[s] = *(const ATT_GAS bf16x8*)(Qp + (size_t)r32 * kld + 16 * s + 8 * hi);
    asm volatile("" : "+v"(qr[0]), "+v"(qr[1]), "+v"(qr[2]), "+v"(qr[3]));
    ATT_LAS bf16x8* qlds = (ATT_LAS bf16x8*)(lds + L_Q + wid * 4096) + lane;
    if (KIND == 1) {
#pragma unroll
        for (int s = 0; s < 4; ++s) qlds[64 * s] = qr[s];
    }
    f32x16 o[NDB];
#pragma unroll
    for (int db = 0; db < NDB; ++db)
#pragma unroll
        for (int r = 0; r < 16; ++r) o[db][r] = 0.f;
    float mrun = 0.f, lrun = 0.f; bool first = true;
    f32x16 negm;
#pragma unroll
    for (int r = 0; r < 16; ++r) negm[r] = 0.f;
    if (KIND == 2) {
#pragma unroll
        for (int tt = 0; tt < 4; ++tt) { *(ATT_LAS u32x4*)(lds + L_K + tt * KSUB + kdst[0]) = k4[tt]; *(ATT_LAS u32x4*)(lds + L_V + tt * VSL + vdst[0]) = v4[tt]; }
    } else ATT_LSTORE(0, 0);
    if (KIND != 2 && t_lo < t_hi) ATT_GLOAD(t_lo + 1);
    asm volatile("s_waitcnt lgkmcnt(0)\n\ts_barrier" ::: "memory");
    const int g16 = lane >> 4, i16 = lane & 15;
    const int voff = (4 * hi + (i16 >> 2)) * VSTR + (16 * (g16 & 1) + 4 * (i16 & 3)) * 2;
    const bool grpB = wid >= 4;
    f32x16 negc;
    { const float cb0 = (KIND == 0) ? bt[256] : 0.f;
#pragma unroll
      for (int r = 0; r < 16; ++r) negc[r] = cb0; }
    bf16x8 pf[2][2];
    int pend = -1, vb = 0;
#define ATT_PV(vslot) do { const ATT_LAS char* vt_ = lds + L_V + (vslot) * VSL + voff; \
        _Pragma("unroll") for (int kb = 0; kb < 2; ++kb) _Pragma("unroll") for (int s = 0; s < 2; ++s) _Pragma("unroll") for (int db = 0; db < NDB; ++db) { \
            const ATT_LAS char* vp = vt_ + (32 * kb + 16 * s) * VSTR + db * 64; const s16x4 lo = vtr(vp), hi4 = vtr(vp + 8 * VSTR); \
            const bf16x8 vf = (bf16x8){lo[0], lo[1], lo[2], lo[3], hi4[0], hi4[1], hi4[2], hi4[3]}; \
            o[db] = __builtin_amdgcn_mfma_f32_32x32x16_bf16(vf, pf[kb][s], o[db], 0, 0, 0); } } while (0)
#pragma unroll 1
    for (int t = t_lo; t <= t_hi; ++t) {
        const int buf = (t - t_lo) & 1;
        if (KIND == 2) vb = t;
        if (pend >= 0) { ATT_PV(pend); pend = -1; }
        if (t >= my_lo && t <= my_hi) {
            const ATT_LAS char* kt = (KIND == 2) ? lds + L_K + t * KSUB : lds + L_K + buf * KBUF + (KIND == 1 ? map * KSUB : 0);
            f32x16 p0, p1;
#define ATT_QK(CINIT) do { _Pragma("unroll") for (int s = 0; s < 4; ++s) { \
                const bf16x8 k0 = *(const ATT_LAS bf16x8*)(kt + r32 * KSTR + s * 32 + hi * 16); \
                const bf16x8 k1 = *(const ATT_LAS bf16x8*)(kt + (r32 + 32) * KSTR + s * 32 + hi * 16); \
                const bf16x8 qf = (KIND == 1) ? qlds[64 * s] : qr[s]; \
                if (s == 0) { p0 = __builtin_amdgcn_mfma_f32_32x32x16_bf16(k0, qf, CINIT, 0, 0, 0); p1 = __builtin_amdgcn_mfma_f32_32x32x16_bf16(k1, qf, CINIT, 0, 0, 0); } \
                else { p0 = __builtin_amdgcn_mfma_f32_32x32x16_bf16(k0, qf, p0, 0, 0, 0); p1 = __builtin_amdgcn_mfma_f32_32x32x16_bf16(k1, qf, p1, 0, 0, 0); } } } while (0)
            const bool farb = (KIND == 0) && (wchunk - t >= 3);
            if (farb) ATT_QK(negc); else ATT_QK(negm);
#undef ATT_QK
            asm volatile("s_nop 15\n\ts_nop 7" : "+v"(p0), "+v"(p1));
            if (KIND == 0) {
                const int j = wchunk - t;
                if (j < 3) {
                    const int base = 128 + 64 * j + 32 * (wid & 1) + r32 - 4 * hi;
#pragma unroll
                    for (int r = 0; r < 16; ++r) {
                        int i0 = base - ((r & 3) + 8 * (r >> 2)); int i1 = i0 - 32;
                        i0 = i0 > 256 ? 256 : i0; i1 = i1 > 256 ? 256 : i1;
                        p0[r] += bt[i0]; p1[r] += bt[i1];
                    }
                }
            }
            float mx = max3f(p0[0], p1[0], p0[1]);
#pragma unroll
            for (int r = 1; r < 15; r += 2) { mx = max3f(mx, p1[r], p0[r + 1]); }
#pragma unroll
            for (int r = 2; r < 16; r += 2) { mx = max3f(mx, p1[r], (r + 1 < 16) ? p0[r + 1] : p1[r]); }
            mx = fmaxf(fmaxf(mx, p1[15]), p0[15]);
            { auto rr = __builtin_amdgcn_permlane32_swap(__float_as_uint(mx), __float_as_uint(mx), false, false);
              mx = fmaxf(fmaxf(__uint_as_float(rr[0]), __uint_as_float(rr[1])), mx); }
            if (first || __any(mx > 8.0f)) {
                const float dl = first ? mx : fmaxf(mx, 0.f);
                first = false;
                mrun += dl;
#pragma unroll
                for (int r = 0; r < 16; ++r) { p0[r] -= dl; p1[r] -= dl; negm[r] = -mrun; if (KIND == 0) negc[r] = bt[256] - mrun; }
                const float alpha = __builtin_amdgcn_exp2f(-dl);
                lrun *= alpha;
#pragma unroll
                for (int db = 0; db < NDB; ++db)
#pragma unroll
                    for (int r = 0; r < 16; ++r) o[db][r] *= alpha;
            }
            float rs0 = 0.f, rs1 = 0.f;
#pragma unroll
            for (int r = 0; r < 16; ++r) { p0[r] = __builtin_amdgcn_exp2f(p0[r]); p1[r] = __builtin_amdgcn_exp2f(p1[r]); rs0 += p0[r]; rs1 += p1[r]; }
            lrun += rs0 + rs1;
#pragma unroll
            for (int s = 0; s < 2; ++s) {
                u32x4 w0, w1;
                w0.x = cvtpk(p0[8 * s + 0], p0[8 * s + 1]); w0.y = cvtpk(p0[8 * s + 2], p0[8 * s + 3]); w0.z = cvtpk(p0[8 * s + 4], p0[8 * s + 5]); w0.w = cvtpk(p0[8 * s + 6], p0[8 * s + 7]);
                w1.x = cvtpk(p1[8 * s + 0], p1[8 * s + 1]); w1.y = cvtpk(p1[8 * s + 2], p1[8 * s + 3]); w1.z = cvtpk(p1[8 * s + 4], p1[8 * s + 5]); w1.w = cvtpk(p1[8 * s + 6], p1[8 * s + 7]);
                pf[0][s] = __builtin_bit_cast(bf16x8, w0); pf[1][s] = __builtin_bit_cast(bf16x8, w1);
            }
            if (grpB) pend = vb; else ATT_PV(vb);
        }
        if (KIND != 2) {
            const int vn = (vb == 2) ? 0 : vb + 1;
            if (t < t_hi) ATT_LSTORE(buf ^ 1, vn);
            if (t + 1 < t_hi) ATT_GLOAD(t + 2);
            vb = vn;
            asm volatile("s_waitcnt lgkmcnt(0)\n\ts_barrier" ::: "memory");
        }
    }
    if (pend >= 0) ATT_PV(pend);
    if (KIND == 1) __syncthreads();
#undef ATT_PV
#undef ATT_GLOAD
#undef ATT_LSTORE
    const float ltot = lrun + __shfl_xor(lrun, 32), inv = 1.0f / ltot;
    if (KIND != 1) {
        ATT_GAS bf16_t* op = a.Ocat + (size_t)(qrow + r32) * 1024 + ocol + 4 * hi;
#pragma unroll
        for (int db = 0; db < NDB; ++db)
#pragma unroll
            for (int g4 = 0; g4 < 4; ++g4) {
                u32x2 w; w.x = cvtpk(o[db][4 * g4 + 0] * inv, o[db][4 * g4 + 1] * inv); w.y = cvtpk(o[db][4 * g4 + 2] * inv, o[db][4 * g4 + 3] * inv);
                *(ATT_GAS u32x2*)(op + 32 * db + 8 * g4) = w;
            }
    } else {
        ATT_LAS float* ex = (ATT_LAS float*)lds + (wid & 3) * 4096;
        if (map == 1) {
#pragma unroll
            for (int db = 0; db < NDB; ++db)
#pragma unroll
                for (int r = 0; r < 16; ++r) ex[(db * 16 + r) * 64 + lane] = o[db][r] * inv;
        }
        __syncthreads();
        if (map == 0) {
            float sq = 0.f;
#pragma unroll
            for (int db = 0; db < NDB; ++db)
#pragma unroll
                for (int r = 0; r < 16; ++r) { const float v = o[db][r] * inv - a.lam * ex[(db * 16 + r) * 64 + lane]; o[db][r] = v; sq += v * v; }
            sq += __shfl_xor(sq, 32);
            const float rsn = rsqrtf(sq * (1.0f / 128.0f) + RMS_EPS) * a.one_m_li;
            ATT_GAS bf16_t* op = a.Ocat + (size_t)(qrow + r32) * 1024 + ocol + 4 * hi;
#pragma unroll
            for (int db = 0; db < NDB; ++db)
#pragma unroll
                for (int g4 = 0; g4 < 4; ++g4) {
                    const f32x4 gn = *(const ATT_GAS f32x4*)(a.subln + 32 * db + 8 * g4 + 4 * hi);
                    u32x2 w; w.x = cvtpk(o[db][4 * g4 + 0] * rsn * gn[0], o[db][4 * g4 + 1] * rsn * gn[1]); w.y = cvtpk(o[db][4 * g4 + 2] * rsn * gn[2], o[db][4 * g4 + 3] * rsn * gn[3]);
                    *(ATT_GAS u32x2*)(op + 32 * db + 8 * g4) = w;
                }
        }
        __syncthreads();
    }
}

__device__ __forceinline__ void attn_phase(ATT_LAS char* lds, const Args& a, int is_b, ATT_GAS unsigned* ctr) {
    volatile ATT_LAS int* misc = (volatile ATT_LAS int*)(lds + L_MISC);
    for (;;) {
        __syncthreads();
        if (threadIdx.x == 0) misc[0] = (int)__hip_atomic_fetch_add(ctr, 1u, __ATOMIC_RELAXED, __HIP_MEMORY_SCOPE_AGENT);
        __syncthreads();
        const int u = __builtin_amdgcn_readfirstlane(misc[0]);
        if (u >= 1024) break;
        if (u < 768) {
#ifndef NO_K1
            if (is_b) attn_unit<1>(lds, a, u);
#endif
#ifndef NO_K0
            if (!is_b) attn_unit<0>(lds, a, u);
#endif
        }
#ifndef NO_K2
        else attn_unit<2>(lds, a, u - 768);
#endif
    }
}
}


#define LAS __attribute__((address_space(3)))
#ifndef PROBE_GEMM2
#define PROBE_GEMM2 0
#endif
#ifndef PROBE_ATT2
#define PROBE_ATT2 0
#endif
#ifndef PROBE_SYNC2
#define PROBE_SYNC2 0
#endif
typedef unsigned short bf16;
typedef float f32x4 __attribute__((ext_vector_type(4)));
typedef unsigned v4u __attribute__((ext_vector_type(4)));
typedef unsigned v2u __attribute__((ext_vector_type(2)));

constexpr int DMODEL = 1024, NBATCH = 4, SEQ = 4096, DEPTH = 4, MTOK = NBATCH * SEQ, DFF = 2816, NMEM = 256, MROWS = NBATCH * NMEM;
constexpr int INW = 2560, SELFW = 768, MEMW = 256;
constexpr int NWAVES = 8;
constexpr size_t MiB = 1u << 20;
constexpr size_t WS_CTL = 0;
constexpr size_t WS_SS = 13 * MiB;
constexpr size_t WS_MRSTD = 2 * MiB;
constexpr size_t WS_COS = 3 * MiB, WS_SIN = 5 * MiB;
constexpr size_t WS_MEMB = 7 * MiB;
constexpr size_t WS_MEMKV = 9 * MiB;
constexpr size_t WS_XB = 16 * MiB;
constexpr size_t WS_W = 48 * MiB, W_LAYER = 41 * MiB;
constexpr size_t WO_GU1 = 0, WO_D1 = 11 * MiB, WO_IN = WO_D1 + 5632 * 1024, WO_MKV = WO_IN + 5 * MiB, WO_OUT = WO_MKV + 1 * MiB, WO_GU2 = WO_OUT + 2 * MiB, WO_D2 = WO_GU2 + 11 * MiB;
static_assert(WO_D2 + 5632 * 1024 == W_LAYER, "weight map");
constexpr size_t WS_ACT = WS_W + DEPTH * W_LAYER;
constexpr size_t AO_Q = 0, AO_K = 24 * MiB, AO_V = 48 * MiB, AO_QM = 72 * MiB, AO_O = 80 * MiB, ACT_BYTES = 112 * MiB;
constexpr size_t WS_XL = WS_ACT + ACT_BYTES;
constexpr size_t WS_END = WS_XL + 32 * MiB;
constexpr int LDS_BYTES = 151552;

struct KArgs { const void* in[28]; float* out; unsigned char* ws; int op_lo, op_hi; };

__device__ __forceinline__ unsigned f2bf(float f) { unsigned u = __builtin_bit_cast(unsigned, f); return (u + 0x7fffu + ((u >> 16) & 1u)) >> 16; }
__device__ __forceinline__ unsigned pk2(float lo, float hi) { return f2bf(lo) | (f2bf(hi) << 16); }
__device__ __forceinline__ float wave_sum(float v) {
#pragma unroll
    for (int o = 1; o < 64; o <<= 1) v += __shfl_xor(v, o);
    return v;
}
__device__ __forceinline__ void transpose_item(const float* W, int K, int N, bf16* WT, const float* gain, LAS float* scr, int item, int lane, int mode) {
    const int nblk = N / 32, kb = item / nblk, nb = item % nblk, k0 = 64 * kb, n0 = 32 * nb;
    int drow0;
    if (mode == 0) drow0 = n0;
    else if (mode == 1) drow0 = 256 * (n0 >> 7) + (n0 & 127);
    else if (mode == 2) drow0 = 256 * (n0 >> 7) + 128 + (n0 & 127);
    else drow0 = 256 * (n0 >> 8) + 128 * ((n0 >> 5) & 1) + 32 * ((n0 >> 6) & 3);
    const int q = lane & 7, r = lane >> 3;
    f32x4 v[8];
#pragma unroll
    for (int i = 0; i < 8; ++i) v[i] = *(const f32x4*)(W + (size_t)(k0 + 8 * i + r) * N + n0 + 4 * q);
    if (gain) {
#pragma unroll
        for (int i = 0; i < 8; ++i) v[i] = v[i] * gain[k0 + 8 * i + r];
    }
#pragma unroll
    for (int i = 0; i < 8; ++i) { LAS float* s = scr + (8 * i + r) * 33 + 4 * q; s[0] = v[i][0]; s[1] = v[i][1]; s[2] = v[i][2]; s[3] = v[i][3]; }
    asm volatile("s_waitcnt lgkmcnt(0)" ::: "memory");
    const int c = lane & 7;
#pragma unroll
    for (int j = 0; j < 4; ++j) { const int n = (lane >> 3) + 8 * j; const LAS float* s = scr + (8 * c) * 33 + n;
        v4u o; o.x = pk2(s[0 * 33], s[1 * 33]); o.y = pk2(s[2 * 33], s[3 * 33]); o.z = pk2(s[4 * 33], s[5 * 33]); o.w = pk2(s[6 * 33], s[7 * 33]);
        *(v4u*)(WT + (size_t)(drow0 + n) * K + k0 + 8 * c) = o; }
    asm volatile("s_waitcnt lgkmcnt(0)" ::: "memory");
}

__device__ __forceinline__ void prologue(const KArgs& A, LAS unsigned char* lds, int tid, int lane, int wave) {
    unsigned char* ws = A.ws;
    LAS float* scr = (LAS float*)(lds + wave * 8448);
    const int G = gridDim.x, gw = blockIdx.x * NWAVES + wave, NGW = G * NWAVES;
    constexpr int I_G = 16 * 88, I_D = 44 * 32, I_IN = 16 * 80, I_MKV = 16 * 16, I_OUT = 16 * 32, I_LAYER = 6 * I_G + I_IN + I_MKV + I_OUT;
    static_assert(I_G == I_D, "items");
    for (int it = gw; it < DEPTH * I_LAYER; it += NGW) {
        const int L = it / I_LAYER; int r = it % I_LAYER;
        bf16* wl = (bf16*)(ws + WS_W + (size_t)L * W_LAYER);
        const size_t o_gu = (size_t)L * DMODEL * DFF, o_n = (size_t)L * DMODEL;
        if (r < I_G) { transpose_item((const float*)A.in[4] + o_gu, DMODEL, DFF, (bf16*)((unsigned char*)wl + WO_GU1), (const float*)A.in[3] + o_n, scr, r, lane, 1); continue; } r -= I_G;
        if (r < I_G) { transpose_item((const float*)A.in[5] + o_gu, DMODEL, DFF, (bf16*)((unsigned char*)wl + WO_GU1), (const float*)A.in[3] + o_n, scr, r, lane, 2); continue; } r -= I_G;
        if (r < I_D) { transpose_item((const float*)A.in[6] + o_gu, DFF, DMODEL, (bf16*)((unsigned char*)wl + WO_D1), nullptr, scr, r, lane, 0); continue; } r -= I_D;
        if (r < I_IN) { transpose_item((const float*)A.in[9] + (size_t)L * DMODEL * INW, DMODEL, INW, (bf16*)((unsigned char*)wl + WO_IN), (const float*)A.in[7] + o_n, scr, r, lane, 3); continue; } r -= I_IN;
        if (r < I_MKV) { transpose_item((const float*)A.in[10] + (size_t)L * DMODEL * 512, DMODEL, 512, (bf16*)((unsigned char*)wl + WO_MKV), (const float*)A.in[8] + o_n, scr, r, lane, 3); continue; } r -= I_MKV;
        if (r < I_OUT) { transpose_item((const float*)A.in[13] + (size_t)L * DMODEL * DMODEL, DMODEL, DMODEL, (bf16*)((unsigned char*)wl + WO_OUT), nullptr, scr, r, lane, 0); continue; } r -= I_OUT;
        if (r < I_G) { transpose_item((const float*)A.in[25] + o_gu, DMODEL, DFF, (bf16*)((unsigned char*)wl + WO_GU2), (const float*)A.in[24] + o_n, scr, r, lane, 1); continue; } r -= I_G;
        if (r < I_G) { transpose_item((const float*)A.in[26] + o_gu, DMODEL, DFF, (bf16*)((unsigned char*)wl + WO_GU2), (const float*)A.in[24] + o_n, scr, r, lane, 2); continue; } r -= I_G;
        transpose_item((const float*)A.in[27] + o_gu, DFF, DMODEL, (bf16*)((unsigned char*)wl + WO_D2), nullptr, scr, r, lane, 0);
    }
    float* ss = (float*)(ws + WS_SS);
    for (int m = gw; m < MTOK + MROWS; m += NGW) {
        const bool ismem = m >= MTOK; const int row = ismem ? m - MTOK : m;
        const f32x4* xr = (const f32x4*)((ismem ? (const float*)A.in[1] : (const float*)A.in[0]) + (size_t)row * DMODEL) + lane;
        f32x4 v[4]; float s = 0.f;
#pragma unroll
        for (int j = 0; j < 4; ++j) { v[j] = xr[64 * j]; s += (v[j].x * v[j].x + v[j].y * v[j].y) + (v[j].z * v[j].z + v[j].w * v[j].w); }
        s = wave_sum(s);
        bf16* ob = (bf16*)(ws + (ismem ? WS_MEMB : WS_XB)) + (size_t)row * DMODEL;
        v2u hw[4];
#pragma unroll
        for (int j = 0; j < 4; ++j) { hw[j].x = pk2(v[j].x, v[j].y); hw[j].y = pk2(v[j].z, v[j].w); *((v2u*)ob + lane + 64 * j) = hw[j]; }
        if (!ismem) {
            unsigned char* ol = ws + WS_XL + (size_t)row * DMODEL;
#pragma unroll
            for (int j = 0; j < 4; ++j) {
                const float r0 = (v[j].x - __builtin_bit_cast(float, hw[j].x << 16)) * 1024.0f, r1 = (v[j].y - __builtin_bit_cast(float, hw[j].x & 0xffff0000u)) * 1024.0f;
                const float r2 = (v[j].z - __builtin_bit_cast(float, hw[j].y << 16)) * 1024.0f, r3 = (v[j].w - __builtin_bit_cast(float, hw[j].y & 0xffff0000u)) * 1024.0f;
                unsigned w = __builtin_amdgcn_cvt_pk_fp8_f32(r0, r1, 0u, false); w = __builtin_amdgcn_cvt_pk_fp8_f32(r2, r3, w, true);
                *((unsigned*)ol + lane + 64 * j) = w; }
            if (lane < 16) ss[(size_t)row * 16 + lane] = (lane == 0) ? s : 0.f;
        } else if (lane == 0) ((float*)(ws + WS_MRSTD))[row] = rsqrtf(s * (1.0f / 1024.0f) + 1e-6f);
    }
    const int gt = blockIdx.x * (NWAVES * 64) + tid, NGT = G * NWAVES * 64;
    const int* pos = (const int*)A.in[2];
    for (int e = gt; e < MTOK * 32; e += NGT) {
        const int row = e >> 5, i = e & 31;
        const float inv_freq = 1.0f / powf(10000.0f, (float)(2 * i) / 64.0f);
        const float ang = (float)pos[row] * inv_freq;
        float sn, cs; sincosf(ang, &sn, &cs);
        ((float*)(ws + WS_COS))[e] = cs; ((float*)(ws + WS_SIN))[e] = sn;
    }
}

#define XB_TMO      128
#define XB_XCNT(j)  (256  + 64 * (j))
#define XB_XSUB(j)  (1280 + 64 * (j))
#define XB_XGEN(j)  (2304 + 64 * (j))
#define XB_TOP      3328
#define XB_TOPGEN   3392
#define XCD_BAR_WORDS 3456
#define XB_SPIN_CAP (1u << 18)

__device__ __forceinline__ unsigned xb_ld(unsigned* p)              { return __hip_atomic_load(p, __ATOMIC_RELAXED, __HIP_MEMORY_SCOPE_AGENT); }
__device__ __forceinline__ unsigned xb_add(unsigned* p, unsigned v) { return __hip_atomic_fetch_add(p, v, __ATOMIC_RELAXED, __HIP_MEMORY_SCOPE_AGENT); }
__device__ __forceinline__ unsigned xb_xcc_id() { return (unsigned)__builtin_amdgcn_s_getreg((3 << 11) | 20) & 0xFu; }
#define XB_SPIN(cond, bar) do { unsigned _sp = 0; while (cond) { __builtin_amdgcn_s_sleep(1); \
    if ((++_sp & 255u) == 0u) { if (xb_ld(&(bar)[XB_TMO])) break; if (_sp > XB_SPIN_CAP) { atomicAdd(&(bar)[XB_TMO], 1u); break; } } } } while (0)

struct XcdBarrier {
    unsigned* bar; unsigned x;
    volatile LAS unsigned* st;
};

__device__ __forceinline__ XcdBarrier xcd_barrier_post(unsigned* bar, volatile LAS unsigned* st) {
    XcdBarrier b; b.bar = bar; b.x = xb_xcc_id(); b.st = st;
    if (threadIdx.x == 0) (void)xb_add(&bar[XB_XCNT(b.x)], 1u);
    return b;
}
__device__ __forceinline__ void xcd_barrier_complete(unsigned* bar, unsigned x, unsigned& nloc, unsigned& nx) {
    const unsigned G = gridDim.x * gridDim.y * gridDim.z;
    unsigned sum, cnt, mine, sp = 0u;
    for (;;) {
        sum = 0u; cnt = 0u; mine = 0u;
#pragma unroll
        for (unsigned j = 0; j < 16; ++j) { const unsigned c = xb_ld(&bar[XB_XCNT(j)]); sum += c; cnt += (c > 0u) ? 1u : 0u; mine = (j == x) ? c : mine; }
        if (sum == G) break;
        __builtin_amdgcn_s_sleep(1);
        if ((++sp & 255u) == 0u) { if (xb_ld(&bar[XB_TMO])) break; if (sp > XB_SPIN_CAP) { atomicAdd(&bar[XB_TMO], 1u); break; } }
    }
    nloc = mine > 0u ? mine : 1u; nx = cnt > 0u ? cnt : 1u;
}

__device__ __forceinline__ void xcd_barrier(const XcdBarrier& b) {
    asm volatile("s_waitcnt vmcnt(0)" ::: "memory");
    __syncthreads();
    if (threadIdx.x == 0) {
        unsigned* bar = b.bar;
        __builtin_amdgcn_s_waitcnt(0);
        unsigned nloc = b.st[0], nx = b.st[1];
        if (nloc == 0u) { xcd_barrier_complete(bar, b.x, nloc, nx); b.st[0] = nloc; b.st[1] = nx; }
        const unsigned old = xb_add(&bar[XB_XSUB(b.x)], 1u);
        const unsigned gen = old / nloc;
        if (old + 1u == (gen + 1u) * nloc) {
            __builtin_amdgcn_fence(__ATOMIC_RELEASE, "agent");
            asm volatile("s_waitcnt vmcnt(0)" ::: "memory");
            const unsigned og = xb_add(&bar[XB_TOP], 1u);
            const unsigned tg = og / nx;
            if (og + 1u == (tg + 1u) * nx) xb_add(&bar[XB_TOPGEN], 1u);
            else XB_SPIN(xb_ld(&bar[XB_TOPGEN]) == tg, bar);
            __builtin_amdgcn_fence(__ATOMIC_ACQUIRE, "agent");
            xb_add(&bar[XB_XGEN(b.x)], 1u);
            asm volatile("s_waitcnt vmcnt(0)" ::: "memory");
        } else {
            XB_SPIN(xb_ld(&bar[XB_XGEN(b.x)]) == gen, bar);
            __builtin_amdgcn_fence(__ATOMIC_ACQUIRE, "agent");
            asm volatile("s_waitcnt vmcnt(0)" ::: "memory");
        }
    }
    __syncthreads();
}

constexpr size_t WS_BAR = 128 * 1024;
constexpr int LDS_BARW = 151552 - 64;

constexpr int NOPS = 4 + 7 * DEPTH;
constexpr size_t WS_TAB = 64 * 1024;
__device__ __forceinline__ void write_table(const KArgs& A) {
    unsigned char* ws = A.ws;
    pg8::OpDesc* tab = (pg8::OpDesc*)(ws + WS_TAB);
    float* ss = (float*)(ws + WS_SS);
    bf16* XB = (bf16*)(ws + WS_XB);
    bf16* HMID = (bf16*)(ws + WS_ACT);
    bf16 *Qs = (bf16*)(ws + WS_ACT + AO_Q), *Ks = (bf16*)(ws + WS_ACT + AO_K), *Vs = (bf16*)(ws + WS_ACT + AO_V), *Qm = (bf16*)(ws + WS_ACT + AO_QM), *Ocat = (bf16*)(ws + WS_ACT + AO_O);
    const float* cosT = (const float*)(ws + WS_COS); const float* sinT = (const float*)(ws + WS_SIN);
#pragma unroll 1
    for (int op = 0; op < NOPS; ++op) {
        pg8::OpDesc* d = tab + op;
#pragma unroll
        for (int i = 0; i < 10; ++i) d->p[i] = nullptr;
        d->f[0] = 0.f; d->f[1] = 0.f; d->i[0] = 0; d->i[1] = 0;
        if (op < 4) {
            const int L = op; const unsigned char* wl = ws + WS_W + (size_t)L * W_LAYER;
            d->type = 2; d->M = MROWS; d->N = 512; d->K = DMODEL; d->A = (const bf16*)(ws + WS_MEMB); d->Bt = (const bf16*)(wl + WO_MKV);
            d->p[0] = ws + WS_MRSTD; d->p[2] = ws + WS_MEMKV + (size_t)L * MiB; d->p[3] = ws + WS_MEMKV + (size_t)L * MiB + MiB / 2; d->p[6] = (const float*)A.in[12] + L * 64;
            d->i[0] = 2; d->i[1] = 128 + 8 * L;
        } else {
            const int L = (op - 4) / 7, k = (op - 4) % 7, j2 = L >> 1; const bool isb = (L & 1) != 0;
            const unsigned char* wl = ws + WS_W + (size_t)L * W_LAYER;
            if (k == 0 || k == 5) {
                d->type = 0; d->M = MTOK; d->N = 2 * DFF; d->K = DMODEL; d->A = XB; d->Bt = (const bf16*)(wl + (k == 0 ? WO_GU1 : WO_GU2));
                d->p[0] = HMID; d->p[1] = ss + (size_t)((3 * L + (k == 0 ? 0 : 2)) % 3) * MTOK * 16;
            } else if (k == 1 || k == 4 || k == 6) {
                d->type = 1; d->M = MTOK; d->N = DMODEL; d->K = (k == 4) ? DMODEL : DFF; d->A = (k == 4) ? Ocat : HMID;
                d->Bt = (const bf16*)(wl + ((k == 1) ? WO_D1 : (k == 4 ? WO_OUT : WO_D2)));
                const int nss = 3 * L + (k == 1 ? 1 : (k == 4 ? 2 : 3));
                d->p[0] = ws + WS_XL; d->p[1] = XB; d->p[2] = ss + (size_t)(nss % 3) * MTOK * 16; d->p[3] = A.out; d->f[0] = (k == 4) ? 1.0f : 0.5f; d->i[0] = (op == NOPS - 1) ? 1 : 0;
            } else if (k == 2) {
                d->type = 2; d->M = MTOK; d->N = INW; d->K = DMODEL; d->A = XB; d->Bt = (const bf16*)(wl + WO_IN);
                d->p[0] = ss + (size_t)((3 * L + 1) % 3) * MTOK * 16; d->p[1] = Qs; d->p[2] = Ks; d->p[3] = Vs; d->p[4] = Qm;
                d->p[5] = (isb ? (const float*)A.in[17] : (const float*)A.in[14]) + j2 * 64; d->p[6] = (isb ? (const float*)A.in[18] : (const float*)A.in[15]) + j2 * 64; d->p[7] = (const float*)A.in[11] + L * 64;
                d->p[8] = cosT; d->p[9] = sinT; d->i[0] = 1 | (isb ? 4 : 0);
            } else {
                d->type = 3; d->M = 0; d->N = 0; d->K = 0; d->A = nullptr; d->Bt = nullptr;
                d->p[0] = Qs; d->p[1] = Ks; d->p[2] = Vs; d->p[3] = Qm; d->p[4] = Ocat; d->p[5] = ws + WS_MEMKV + (size_t)L * MiB; d->p[6] = ws + WS_MEMKV + (size_t)L * MiB + MiB / 2;
                d->p[7] = (const float*)A.in[16] + (size_t)j2 * 12 * 257; d->p[8] = (const float*)A.in[23] + j2 * 128; d->p[9] = (unsigned*)(ws + WS_CTL) + 16 * L;
                d->i[0] = isb ? 1 : 0; d->f[1] = 1.f;
                if (isb) {
                    const float li = 0.8f - 0.6f * expf(-0.3f * (float)L);
                    const float *q1 = (const float*)A.in[19] + j2 * 64, *k1 = (const float*)A.in[20] + j2 * 64, *q2 = (const float*)A.in[21] + j2 * 64, *k2 = (const float*)A.in[22] + j2 * 64;
                    float s1 = 0.f, s2 = 0.f;
#pragma unroll 1
                    for (int i = 0; i < 64; ++i) { s1 += q1[i] * k1[i]; s2 += q2[i] * k2[i]; }
                    d->f[0] = expf(s1) - expf(s2) + li; d->f[1] = 1.0f - li;
                }
            }
        }
    }
}

__global__ void __launch_bounds__(NWAVES * 64, 2) mega_fwd(KArgs A) {
    extern __shared__ __attribute__((aligned(16))) unsigned char lds_raw[];
    cg::grid_group grid = cg::this_grid();
    LAS unsigned char* lds = (LAS unsigned char*)lds_raw;
    const int tid = threadIdx.x, lane = tid & 63, wave = __builtin_amdgcn_readfirstlane(tid >> 6);
    if (tid < 2) ((volatile LAS unsigned*)(lds + LDS_BARW))[tid] = 0u;
    __syncthreads();
    XcdBarrier xbar = xcd_barrier_post((unsigned*)(A.ws + WS_BAR), (volatile LAS unsigned*)(lds + LDS_BARW));
    if (A.op_lo < 0) {
#ifndef NO_TAB
        if (blockIdx.x == 0 && tid == 0) write_table(A);
#endif
#ifndef NO_PRO
        prologue(A, lds, tid, lane, wave);
#endif
        if (A.op_hi > 0) xcd_barrier(xbar);
        if (A.op_hi < -5) grid.sync();
    }
    const pg8::OpDesc* tab = (const pg8::OpDesc*)(A.ws + WS_TAB);
    const int op_lo = A.op_lo < 0 ? 0 : A.op_lo, op_hi = A.op_hi;
#pragma unroll 1
    for (int op = op_lo; op < op_hi; ++op) {
        const pg8::OpDesc* d = tab + op;
        const int type = __builtin_amdgcn_readfirstlane(d->type);
        if (type == 3) {
            att::Args a;
            a.Qs = (const ATT_GAS bf16*)d->p[0]; a.Ks = (const ATT_GAS bf16*)d->p[1]; a.Vs = (const ATT_GAS bf16*)d->p[2]; a.Qm = (const ATT_GAS bf16*)d->p[3]; a.Ocat = (ATT_GAS bf16*)d->p[4];
            a.memK = (const ATT_GAS bf16*)d->p[5]; a.memV = (const ATT_GAS bf16*)d->p[6]; a.relb = (const ATT_GAS float*)d->p[7]; a.subln = (const ATT_GAS float*)d->p[8];
            a.lam = d->f[0]; a.one_m_li = d->f[1];
#ifndef NO_ATT
            att::attn_phase((__attribute__((address_space(3))) char*)lds, a, d->i[0], (ATT_GAS unsigned*)d->p[9]);
#if PROBE_ATT2
            xcd_barrier(xbar);
            att::attn_phase((__attribute__((address_space(3))) char*)lds, a, d->i[0], (ATT_GAS unsigned*)d->p[9] + 8);
#endif
#endif
        } else {
            const int G = gridDim.x, bx = blockIdx.x;
            pg8::Gemm g{(const pg8::bf16_t*)(const ATT_GAS pg8::bf16_t*)d->A, (const pg8::bf16_t*)(const ATT_GAS pg8::bf16_t*)d->Bt, d->M, d->N, d->K};
            pg8::StaticOrder S; S.init(d->M, d->N, G, (((bx - d->i[1]) % G) + G) % G);
#if PROBE_GEMM2
            for (int rep = ((PROBE_GEMM2 >> type) & 1) ? 0 : 1; rep < 2; ++rep) {
            if (rep == 1 && ((PROBE_GEMM2 >> type) & 1)) xcd_barrier(xbar);
#endif
#ifndef NO_GU
            if (type == 0) { pg8::EpiGateUp E{d}; pg8::gemm_phase<pg8::EpiGateUp, pg8::StaticOrder, true, true>(lds, g, S, E); }
#endif
#ifndef NO_RES
#if PROBE_GEMM2
            const float smul = (rep == 0) ? 0.f : 1.f;
#else
            const float smul = 1.f;
#endif
            if (type == 1) { pg8::EpiResid E{d, smul}; pg8::gemm_phase<pg8::EpiResid, pg8::StaticOrder, true, true>(lds, g, S, E); }
#endif
#ifndef NO_PROJ
            if (type == 2) { pg8::EpiProj E{d}; pg8::gemm_phase<pg8::EpiProj, pg8::StaticOrder, true, true>(lds, g, S, E); }
#endif
#if PROBE_GEMM2
            }
#endif
        }
        if (op >= 4 && op + 1 < op_hi) xcd_barrier(xbar);
#if PROBE_SYNC2
        if (op >= 4 && op + 1 < op_hi) { xcd_barrier(xbar); xcd_barrier(xbar); xcd_barrier(xbar); xcd_barrier(xbar); }
#endif
    }
}

extern "C" void kernel_launch(void* const* d_in, const int* in_sizes, int n_in, void* d_out, int out_size, void* d_ws, size_t ws_size, hipStream_t stream) {
    static int grid = 0;
    if (grid == 0) {
        if (n_in != 28 || out_size != MTOK * DMODEL || ws_size < WS_END) { fprintf(stderr, "kernel_launch: unexpected problem (n_in %d, out %d, ws %zu < %zu)\n", n_in, out_size, ws_size, (size_t)WS_END); grid = -1; return; }
        int dev = 0, cus = 0, per_cu = 0;
        hipGetDevice(&dev); hipDeviceGetAttribute(&cus, hipDeviceAttributeMultiprocessorCount, dev);
        if (hipFuncSetAttribute((const void*)mega_fwd, hipFuncAttributeMaxDynamicSharedMemorySize, LDS_BYTES) != hipSuccess) { fprintf(stderr, "kernel_launch: hipFuncSetAttribute failed\n"); grid = -1; return; }
        if (hipOccupancyMaxActiveBlocksPerMultiprocessor(&per_cu, (const void*)mega_fwd, NWAVES * 64, LDS_BYTES) != hipSuccess || per_cu < 1) { fprintf(stderr, "kernel_launch: occupancy query gives %d\n", per_cu); per_cu = 1; }
        (void)hipGetLastError();
        grid = cus * per_cu;
        fprintf(stderr, "kernel_launch: grid %d (cus %d x %d)\n", grid, cus, per_cu);
    }
    if (grid < 0) return;
    if (hipMemsetAsync((char*)d_ws + WS_CTL, 0, 256 * 1024, stream) != hipSuccess) { fprintf(stderr, "kernel_launch: memset failed\n"); return; }
    KArgs a{};
    for (int i = 0; i < 28; ++i) a.in[i] = d_in[i];
    a.out = (float*)d_out; a.ws = (unsigned char*)d_ws; a.op_lo = -1; a.op_hi = NOPS;
    void* params[] = {&a};
    hipError_t e = hipLaunchCooperativeKernel((const void*)mega_fwd, dim3(grid), dim3(NWAVES * 64), params, LDS_BYTES, stream);
    if (e != hipSuccess) fprintf(stderr, "kernel_launch: cooperative launch failed: %s (grid %d)\n", hipGetErrorString(e), grid);
}
```
